# Optimizing an MI355X kernel written in HIP

```python
import math
import jax, jax.numpy as jnp
from jax import lax
import numpy as np

D_MODEL = 1024
BATCH = 16
SEQ = 2048
DEPTH = 2

CHUNK = 64
N_META = 16
SSM_WIDTH = D_MODEL // 2
SSM_GROUP = 16
N_SSM_GROUPS = SSM_WIDTH // SSM_GROUP
SSM_STATE = 64
HEAD_DIM = 64
ATTN_HEADS = (D_MODEL // 2) // HEAD_DIM
ATTN_WIDTH = ATTN_HEADS * HEAD_DIM
Q_BLOCK = 128
D_FF = 2816
N_BRANCH = 2
RMS_EPS = 1e-6
DT_MIN, DT_MAX = 1e-3, 1e-1
IN_WIDTH = SSM_WIDTH + 3 * ATTN_WIDTH + ATTN_HEADS + N_BRANCH * D_MODEL

kernel_name = "hybrid_s5_fox_macaron_meta"


def rmsnorm(x, g):
    xf = x.astype(jnp.float32)
    y = xf * lax.rsqrt(jnp.mean(xf * xf, axis=-1, keepdims=True) + RMS_EPS)
    return (y * g.astype(jnp.float32)).astype(x.dtype)


def swiglu(h, w_gate, w_up, w_down):
    return (jax.nn.silu(h @ w_gate) * (h @ w_up)) @ w_down


def _complex_combine(left, right):
    a1r, a1i, b1r, b1i = left
    a2r, a2i, b2r, b2i = right
    return (a2r * a1r - a2i * a1i,
            a2r * a1i + a2i * a1r,
            a2r * b1r - a2i * b1i + b2r,
            a2r * b1i + a2i * b1r + b2i)


def s5_mixer(u, a_re, a_im, log_dt, b_re, b_im, c_re, c_im, d_skip, w_glu):
    f32 = jnp.float32
    bsz, L, _ = u.shape
    ug = u.astype(f32).reshape(bsz, L, N_SSM_GROUPS, SSM_GROUP)
    dt = jnp.exp(log_dt.astype(f32))[:, None]
    lam_re = a_re.astype(f32)
    lam_im = a_im.astype(f32)
    mag = jnp.exp(lam_re * dt)
    ab_re = mag * jnp.cos(lam_im * dt)
    ab_im = mag * jnp.sin(lam_im * dt)
    den = lam_re * lam_re + lam_im * lam_im
    n_re = ab_re - 1.0
    coef_re = (n_re * lam_re + ab_im * lam_im) / den
    coef_im = (ab_im * lam_re - n_re * lam_im) / den
    bu_re = jnp.einsum('blgc,gpc->blgp', ug, b_re.astype(f32))
    bu_im = jnp.einsum('blgc,gpc->blgp', ug, b_im.astype(f32))
    bb_re = coef_re * bu_re - coef_im * bu_im
    bb_im = coef_re * bu_im + coef_im * bu_re
    a_r = jnp.broadcast_to(ab_re, bb_re.shape)
    a_i = jnp.broadcast_to(ab_im, bb_im.shape)
    _, _, h_re, h_im = lax.associative_scan(_complex_combine, (a_r, a_i, bb_re, bb_im), axis=1)
    y = (jnp.einsum('blgp,gcp->blgc', h_re, c_re.astype(f32))
         - jnp.einsum('blgp,gcp->blgc', h_im, c_im.astype(f32))
         + d_skip.astype(f32).reshape(N_SSM_GROUPS, SSM_GROUP) * ug)
    y = jax.nn.gelu(y.reshape(bsz, L, SSM_WIDTH)).astype(u.dtype)
    z = y @ w_glu
    return z[..., :SSM_WIDTH] * jax.nn.sigmoid(z[..., SSM_WIDTH:])


def forgetting_attention(q, k, v, f_logit):
    L = q.shape[1]
    log_f = jax.nn.log_sigmoid(f_logit.astype(jnp.float32))
    cum = jnp.cumsum(log_f, axis=1).transpose(0, 2, 1)
    scale = HEAD_DIM ** -0.5
    outs = []
    for start in range(0, L, Q_BLOCK):
        end = min(start + Q_BLOCK, L)
        qb = q[:, start:end]
        kb = k[:, :end]
        vb = v[:, :end]
        s = jnp.einsum('bqhd,bkhd->bhqk', qb, kb).astype(jnp.float32) * scale
        s = s + cum[:, :, start:end, None] - cum[:, :, None, :end]
        causal = jnp.arange(end)[None, :] <= jnp.arange(start, end)[:, None]
        s = jnp.where(causal, s, -jnp.inf)
        p = jax.nn.softmax(s, axis=-1)
        outs.append(jnp.einsum('bhqk,bkhd->bqhd', p.astype(v.dtype), vb))
    return jnp.concatenate(outs, axis=1)


def setup_inputs(seed: int = 0) -> dict:
    key = jax.random.key(seed)
    ks = iter(jax.random.split(key, 40))
    f32 = jnp.float32

    def nrm(shape, scale):
        return jax.random.normal(next(ks), shape, f32) * scale

    def gain(shape):
        return 1.0 + nrm(shape, 0.02)

    G, P, C = N_SSM_GROUPS, SSM_STATE, SSM_GROUP
    x = jax.random.normal(next(ks), (BATCH, SEQ, D_MODEL), f32)
    meta = nrm((N_META, D_MODEL), 1.0)
    g_ffn1 = gain((DEPTH, D_MODEL))
    w1_gate = nrm((DEPTH, D_MODEL, D_FF), D_MODEL ** -0.5)
    w1_up = nrm((DEPTH, D_MODEL, D_FF), D_MODEL ** -0.5)
    w1_down = nrm((DEPTH, D_FF, D_MODEL), D_FF ** -0.5)
    g_mix = gain((DEPTH, D_MODEL))
    w_in = nrm((DEPTH, D_MODEL, IN_WIDTH), D_MODEL ** -0.5)
    b_gate = nrm((DEPTH, N_BRANCH * D_MODEL), 0.02)
    b_f = 2.0 + nrm((DEPTH, ATTN_HEADS), 0.5)
    n_idx = jnp.arange(P, dtype=f32)
    ssm_a_re = -0.5 + nrm((DEPTH, G, P), 0.01)
    ssm_a_im = math.pi * n_idx + nrm((DEPTH, G, P), 0.01)
    ssm_log_dt = jax.random.uniform(next(ks), (DEPTH, G), f32,
                                    minval=math.log(DT_MIN), maxval=math.log(DT_MAX))
    ssm_b_re = nrm((DEPTH, G, P, C), (2.0 * C) ** -0.5)
    ssm_b_im = nrm((DEPTH, G, P, C), (2.0 * C) ** -0.5)
    ssm_c_re = nrm((DEPTH, G, C, P), (2.0 * P) ** -0.5 * 4.0)
    ssm_c_im = nrm((DEPTH, G, C, P), (2.0 * P) ** -0.5 * 4.0)
    ssm_d = nrm((DEPTH, SSM_WIDTH), 1.0)
    w_glu = nrm((DEPTH, SSM_WIDTH, 2 * SSM_WIDTH), SSM_WIDTH ** -0.5)
    w_br_a = nrm((DEPTH, SSM_WIDTH, D_MODEL), SSM_WIDTH ** -0.5)
    w_br_b = nrm((DEPTH, ATTN_WIDTH, D_MODEL), ATTN_WIDTH ** -0.5)
    w_o = nrm((DEPTH, D_MODEL, D_MODEL), D_MODEL ** -0.5)
    g_ffn2 = gain((DEPTH, D_MODEL))
    w2_gate = nrm((DEPTH, D_MODEL, D_FF), D_MODEL ** -0.5)
    w2_up = nrm((DEPTH, D_MODEL, D_FF), D_MODEL ** -0.5)
    w2_down = nrm((DEPTH, D_FF, D_MODEL), D_FF ** -0.5)
    g_final = gain((D_MODEL,))
    return {"x": x, "meta": meta,
            "g_ffn1": g_ffn1, "w1_gate": w1_gate, "w1_up": w1_up, "w1_down": w1_down,
            "g_mix": g_mix, "w_in": w_in, "b_gate": b_gate, "b_f": b_f,
            "ssm_a_re": ssm_a_re, "ssm_a_im": ssm_a_im, "ssm_log_dt": ssm_log_dt,
            "ssm_b_re": ssm_b_re, "ssm_b_im": ssm_b_im, "ssm_c_re": ssm_c_re, "ssm_c_im": ssm_c_im,
            "ssm_d": ssm_d, "w_glu": w_glu, "w_br_a": w_br_a, "w_br_b": w_br_b, "w_o": w_o,
            "g_ffn2": g_ffn2, "w2_gate": w2_gate, "w2_up": w2_up, "w2_down": w2_down,
            "g_final": g_final}


def reference(x, meta, g_ffn1, w1_gate, w1_up, w1_down, g_mix, w_in, b_gate, b_f,
              ssm_a_re, ssm_a_im, ssm_log_dt, ssm_b_re, ssm_b_im, ssm_c_re, ssm_c_im,
              ssm_d, w_glu, w_br_a, w_br_b, w_o, g_ffn2, w2_gate, w2_up, w2_down, g_final):
    bsz = x.shape[0]
    h = jnp.concatenate([jnp.broadcast_to(meta[None].astype(x.dtype), (bsz, N_META, D_MODEL)), x], axis=1)
    L = h.shape[1]
    o_u = 0
    o_q = o_u + SSM_WIDTH
    o_k = o_q + ATTN_WIDTH
    o_v = o_k + ATTN_WIDTH
    o_f = o_v + ATTN_WIDTH
    o_g = o_f + ATTN_HEADS
    for l in range(DEPTH):
        h = h + 0.5 * swiglu(rmsnorm(h, g_ffn1[l]), w1_gate[l], w1_up[l], w1_down[l])
        n = rmsnorm(h, g_mix[l])
        z = n @ w_in[l]
        u = z[..., o_u:o_q]
        q = z[..., o_q:o_k].reshape(bsz, L, ATTN_HEADS, HEAD_DIM)
        k = z[..., o_k:o_v].reshape(bsz, L, ATTN_HEADS, HEAD_DIM)
        v = z[..., o_v:o_f].reshape(bsz, L, ATTN_HEADS, HEAD_DIM)
        f_logit = z[..., o_f:o_g] + b_f[l]
        gates = jax.nn.sigmoid(z[..., o_g:] + b_gate[l])
        y_a = s5_mixer(u, ssm_a_re[l], ssm_a_im[l], ssm_log_dt[l], ssm_b_re[l], ssm_b_im[l],
                       ssm_c_re[l], ssm_c_im[l], ssm_d[l], w_glu[l])
        y_b = forgetting_attention(q, k, v, f_logit).reshape(bsz, L, ATTN_WIDTH)
        merged = gates[..., :D_MODEL] * (y_a @ w_br_a[l]) + gates[..., D_MODEL:] * (y_b @ w_br_b[l])
        h = h + merged @ w_o[l]
        h = h + 0.5 * swiglu(rmsnorm(h, g_ffn2[l]), w2_gate[l], w2_up[l], w2_down[l])
    return rmsnorm(h[:, N_META:], g_final)
```

```cpp
#include <hip/hip_runtime.h>
#include <hip/hip_cooperative_groups.h>
#include <cstdio>
#include <cstdint>
namespace cg = cooperative_groups;

#ifndef MK_SKIP
#define MK_SKIP 0
#endif
#ifndef REP_ATTN
#define REP_ATTN 1
#endif
#ifndef REP_SSM
#define REP_SSM 1
#endif
#ifndef MK_MULTI
#define MK_MULTI 0
#endif

constexpr int D = 1024, NB = 16, SEQ = 2048, NMETA = 16, LPOS = SEQ + NMETA, T = NB * LPOS, TREAL = NB * SEQ;
constexpr int DFF = 2816, SW = 512, AW = 512, NH = 8, HD = 64, INW = 4104, NG = 32, NP = 64, NC = 16;
constexpr int NSEG = 4;
constexpr float RMS_EPS = 1e-6f, LOG2E = 1.4426950408889634f;
static_assert(T == 129 * 256, "row tiling");

typedef unsigned short bf16_t;
typedef short bf16x8 __attribute__((ext_vector_type(8)));
typedef float f32x4 __attribute__((ext_vector_type(4)));
typedef unsigned u32x4 __attribute__((ext_vector_type(4)));
typedef unsigned u32x2 __attribute__((ext_vector_type(2)));
#define LAS __attribute__((address_space(3)))

constexpr size_t MiB = 1u << 20;
constexpr size_t WS_HMETA = 0;
constexpr size_t WS_SSQM = 512 * 1024;
constexpr size_t WS_KMAX = 576 * 1024;
constexpr size_t WS_QMAX = 640 * 1024;
constexpr size_t WS_FLOG = 2 * MiB;
constexpr size_t WS_CUM = 4 * MiB;
constexpr size_t WS_SSMS = 6 * MiB;
constexpr size_t WS_BAR = 9 * MiB + 512 * 1024;
constexpr size_t BAR_BYTES = 16384;
constexpr size_t WS_W = 10 * MiB;
constexpr size_t WO_W1 = 0, WO_W2 = WO_W1 + (size_t)5632 * 1024, WO_WIN = WO_W2 + (size_t)1024 * 2816, WO_WV = WO_WIN + (size_t)3840 * 1024,
                 WO_GLU = WO_WV + (size_t)512 * 1024, WO_BA = WO_GLU + (size_t)1024 * 512, WO_BB = WO_BA + (size_t)1024 * 512, WO_O = WO_BB + (size_t)1024 * 512,
                 WO_W1B = WO_O + (size_t)1024 * 1024, WO_W2B = WO_W1B + (size_t)5632 * 1024, W_LAYER = WO_W2B + (size_t)1024 * 2816;
constexpr size_t WS_XN = WS_W + ((2 * W_LAYER * 2 + MiB - 1) / MiB) * MiB;
constexpr size_t XN_BYTES = (((size_t)T * 1024 * 2 + MiB - 1) / MiB) * MiB;
constexpr size_t WS_R = WS_XN + XN_BYTES;
constexpr size_t SZ512 = (size_t)T * 512 * 2;
constexpr size_t WS_U = WS_R, WS_Q = WS_U + SZ512, WS_K = WS_Q + SZ512, WS_VT = WS_K + SZ512, WS_GATES = WS_VT + SZ512, WS_YB = WS_GATES + (size_t)T * 2048 * 2, WS_SSQ = WS_YB + SZ512, WS_YSSM = WS_SSQ + (size_t)T * 4 * 4, WS_END = WS_YSSM + SZ512;
static_assert(WS_R + (size_t)T * 2816 * 2 <= WS_END, "ffn hidden fits in the overlay");

struct Params { const float* in[27]; float* out; unsigned char* ws; int ph_lo, ph_hi; };
#define GAS __attribute__((address_space(1)))
typedef const __attribute__((address_space(4))) struct Params* KP;
#define PIN(i) ((const float*)(const GAS float*)(Pk->in[i]))
#define PWS ((unsigned char*)(GAS unsigned char*)(Pk->ws))
#define POUT ((float*)(GAS float*)(Pk->out))

__device__ __forceinline__ unsigned f2bf(float f) { unsigned u = __builtin_bit_cast(unsigned, f); return (u + 0x7fffu + ((u >> 16) & 1u)) >> 16; }
__device__ __forceinline__ unsigned pk2(float lo, float hi) { return f2bf(lo) | (f2bf(hi) << 16); }
__device__ __forceinline__ float bf_lo(unsigned w) { return __builtin_bit_cast(float, w << 16); }
__device__ __forceinline__ float bf_hi(unsigned w) { return __builtin_bit_cast(float, w & 0xffff0000u); }
__device__ __forceinline__ float fast_exp2(float x) { return __builtin_amdgcn_exp2f(x); }
__device__ __forceinline__ float fast_rcp(float x) { return __builtin_amdgcn_rcpf(x); }
__device__ __forceinline__ float sigmoidf_(float x) { return fast_rcp(1.0f + fast_exp2(-x * LOG2E)); }
__device__ __forceinline__ float wave_sum(float v) {
#pragma unroll
    for (int o = 1; o < 64; o <<= 1) v += __shfl_xor(v, o);
    return v;
}
__device__ __forceinline__ int row_of(int b, int p) { return p < NMETA ? TREAL + p : b * SEQ + p - NMETA; }

namespace pg8 {
constexpr int BM = 256, BK = 64, HALF = 128, HTB = HALF * BK * 2, STAGE_BYTES = 8 * HTB, NXCD = 8, WGM = 8;
__host__ __device__ __forceinline__ int lds_byte(int r, int c) { const int st = (r >> 4) * 2 + (c >> 5), rr = r & 15, cc = c & 31, ob = rr * 64 + cc * 2; return st * 1024 + (ob ^ (((ob >> 9) & 1) << 5)); }
__host__ __device__ __forceinline__ void stage_rc(int b, int& R, int& C) { const int st = b / 1024, sb = b % 1024, swz = sb ^ (((sb >> 9) & 1) << 5); R = (st >> 1) * 16 + swz / 64; C = (st & 1) * 32 + (swz % 64) / 2; }
__host__ __device__ __forceinline__ int perm32(int rho) { const int n = rho >> 4, i = rho & 15; return 8 * (i >> 2) + 4 * n + (i & 3); }

struct Unit { int pm, pn, sub; };
struct Gemm { const bf16_t* A0; const bf16_t* B0; const bf16_t* A1; const bf16_t* B1; int K; };

struct Sched2 {
    int nM0, nN0, nwg0, nM1, nN1, nwg1, G, c, pair;
    __device__ void init(int M0, int N0, int M1, int N1, int G_, int c_) { nM0 = M0 / BM; nN0 = N0 / BM; nwg0 = nM0 * nN0; nM1 = M1 / BM; nN1 = N1 / BM; nwg1 = nM1 * nN1; G = G_; c = c_; pair = 0; }
    __device__ static void map(int wgid, int nwg, int nM, int nN, Unit& u) {
        { const int q = nwg / NXCD, r = nwg % NXCD, xcd = wgid % NXCD, off = wgid / NXCD; wgid = (xcd < r ? xcd * (q + 1) : r * (q + 1) + (xcd - r) * q) + off; }
        const int nig = WGM * nN, gid = wgid / nig, fm = gid * WGM, gsz = (nM - fm) < WGM ? (nM - fm) : WGM;
        u.pm = fm + ((wgid % nig) % gsz); u.pn = (wgid % nig) / gsz;
    }
    __device__ bool next(int i, Unit& u) const {
        if (pair) {
            const long Lp = (long)(i >> 1) * G + c; if (Lp >= nwg0) return false;
            u.sub = i & 1; map((int)Lp, nwg0, nM0, nN0, u); return true; }
        long L = (long)i * G + c; if (L >= nwg0 + nwg1) return false;
        if (L < nwg0) { u.sub = 0; map((int)L, nwg0, nM0, nN0, u); } else { u.sub = 1; map((int)L - nwg0, nwg1, nM1, nN1, u); }
        return true;
    }
};

typedef float f32x2_t __attribute__((ext_vector_type(2))); typedef __bf16 bf16x2_t __attribute__((ext_vector_type(2)));
__device__ __forceinline__ unsigned cvt_pk_bf16(float lo, float hi) { f32x2_t v = {lo, hi}; bf16x2_t b = __builtin_convertvector(v, bf16x2_t); return __builtin_bit_cast(unsigned, b); }

template <class Epi>
__device__ __forceinline__ void gemm_phase(LAS unsigned char* lds, const Gemm g, const Sched2& S, const Epi& E) {
    int tid_ = threadIdx.x; asm volatile("" : "+v"(tid_));
    const int tid = tid_, wid = __builtin_amdgcn_readfirstlane(tid >> 6), lane = tid & 63, wr = wid >> 2, wc = wid & 3, fr = lane & 15, fq = lane >> 4;
    const int K = g.K, nt = K / BK;
    unsigned voffA[2], voffB[2];
#pragma unroll
    for (int i = 0; i < 2; ++i) { int R, C; stage_rc(tid * 16 + i * 8192, R, C); const int Rb = Epi::PERM ? ((R & ~31) + perm32(R & 31)) : R;
        voffA[i] = (unsigned)(R * K + C) * 2u; voffB[i] = (unsigned)(Rb * K + C) * 2u; }
    const size_t kstep = (size_t)(BK * 2);
    const size_t hstep = (size_t)HALF * K * 2;
    const size_t tstep = 2 * hstep;
    const unsigned ldsw = (unsigned)wid * 1024u;
    const int aoff = lds_byte(wr * 64 + fr, fq * 8), boff = lds_byte(wc * 32 + fr, fq * 8);
#define PG8_SA(b, h) (((b) * 2 + (h)) * HTB)
#define PG8_SB(b, h) ((4 + (b) * 2 + (h)) * HTB)
#define PG8_STAGE(bufoff, gbase, voff) do { _Pragma("unroll") for (int _i = 0; _i < 2; ++_i) \
        __builtin_amdgcn_global_load_lds((const unsigned*)((const char*)(gbase) + (voff)[_i]), (LAS unsigned*)(lds + (bufoff) + ldsw + _i * 8192), 16, 0, 0); } while (0)
#define PG8_LDA(dst, b, h) do { _Pragma("unroll") for (int m = 0; m < 4; ++m) _Pragma("unroll") for (int k = 0; k < 2; ++k) dst[m][k] = *(const LAS bf16x8*)(lds + PG8_SA(b, h) + aoff + m * 2048 + k * 1024); } while (0)
#define PG8_LDB(dst, b, h) do { _Pragma("unroll") for (int n = 0; n < 2; ++n) _Pragma("unroll") for (int k = 0; k < 2; ++k) dst[n][k] = *(const LAS bf16x8*)(lds + PG8_SB(b, h) + boff + n * 2048 + k * 1024); } while (0)
#define PG8_MMA(ai, bj, At, Bt) do { __builtin_amdgcn_s_setprio(1); _Pragma("unroll") for (int m = 0; m < 4; ++m) _Pragma("unroll") for (int n = 0; n < 2; ++n) _Pragma("unroll") for (int k = 0; k < 2; ++k) \
        acc[ai][bj][m][n] = __builtin_amdgcn_mfma_f32_16x16x32_bf16(Bt[n][k], At[m][k], acc[ai][bj][m][n], 0, 0, 0); __builtin_amdgcn_s_setprio(0); } while (0)
#define PG8_WAIT_V(n) asm volatile("s_waitcnt vmcnt(" #n ")" ::: "memory")
#define PG8_WAIT_L(n) asm volatile("s_waitcnt lgkmcnt(" #n ")" ::: "memory")
#define PG8_BAR __builtin_amdgcn_s_barrier()
#define PG8_SCHED __builtin_amdgcn_sched_barrier(0)
    Unit cur, nxt; int ui = 0;
    if (!S.next(0, cur)) return;
    f32x4 acc[2][2][4][2];
#pragma unroll
    for (int a = 0; a < 2; ++a)
#pragma unroll
        for (int b = 0; b < 2; ++b)
#pragma unroll
            for (int m = 0; m < 4; ++m)
#pragma unroll
                for (int n = 0; n < 2; ++n) acc[a][b][m][n] = (f32x4){0.f, 0.f, 0.f, 0.f};
    bf16x8 At[4][2], B0[2][2], B1[2][2];
    const char* cA = (const char*)(cur.sub ? g.A1 : g.A0) + (size_t)cur.pm * tstep; const char* cB = (const char*)(cur.sub ? g.B1 : g.B0) + (size_t)cur.pn * tstep;
    {
        PG8_STAGE(PG8_SB(0, 0), cB, voffB); PG8_STAGE(PG8_SB(0, 1), cB + hstep, voffB); PG8_STAGE(PG8_SA(0, 0), cA, voffA); PG8_STAGE(PG8_SA(0, 1), cA + hstep, voffA);
        if (wr == 1) PG8_BAR;
        PG8_WAIT_V(2); PG8_BAR;
        PG8_STAGE(PG8_SB(1, 0), cB + kstep, voffB); PG8_STAGE(PG8_SA(1, 0), cA + kstep, voffA); PG8_STAGE(PG8_SB(1, 1), cB + hstep + kstep, voffB);
        PG8_WAIT_V(6); PG8_BAR;
    }
    for (;;) {
        const bool has_next = S.next(ui + 1, nxt);
        const char* nA = has_next ? (const char*)(nxt.sub ? g.A1 : g.A0) + (size_t)nxt.pm * tstep : cA; const char* nB = has_next ? (const char*)(nxt.sub ? g.B1 : g.B0) + (size_t)nxt.pn * tstep : cB;
        for (int t = 0; t < nt; t += 2) {
            const bool last = (t == nt - 2);
            const char* a1 = cA + (size_t)(t + 1) * kstep;
            const char* a2 = last ? nA : cA + (size_t)(t + 2) * kstep; const char* b2 = last ? nB : cB + (size_t)(t + 2) * kstep;
            const char* a3 = a2 + kstep; const char* b3 = b2 + kstep;
            PG8_LDB(B0, 0, 0); PG8_LDB(B1, 0, 1); PG8_SCHED; PG8_LDA(At, 0, 0); PG8_STAGE(PG8_SA(1, 1), a1 + hstep, voffA);
            PG8_WAIT_V(8); PG8_WAIT_L(0); PG8_BAR; PG8_MMA(0, 0, At, B0); PG8_MMA(0, 1, At, B1); PG8_BAR; PG8_SCHED;
            PG8_LDA(At, 0, 1); PG8_STAGE(PG8_SB(0, 0), b2, voffB); PG8_STAGE(PG8_SB(0, 1), b2 + hstep, voffB); PG8_STAGE(PG8_SA(0, 0), a2, voffA);
            PG8_WAIT_V(8); PG8_WAIT_L(0); PG8_BAR; PG8_MMA(1, 0, At, B0); PG8_MMA(1, 1, At, B1); PG8_BAR; PG8_SCHED;
            PG8_LDB(B0, 1, 0); PG8_LDB(B1, 1, 1); PG8_SCHED; PG8_LDA(At, 1, 0); PG8_STAGE(PG8_SA(0, 1), a2 + hstep, voffA);
            PG8_WAIT_V(8); PG8_WAIT_L(0); PG8_BAR; PG8_MMA(0, 0, At, B0); PG8_MMA(0, 1, At, B1); PG8_BAR; PG8_SCHED;
            PG8_LDA(At, 1, 1); PG8_STAGE(PG8_SB(1, 0), b3, voffB); PG8_STAGE(PG8_SB(1, 1), b3 + hstep, voffB); PG8_STAGE(PG8_SA(1, 0), a3, voffA);
            PG8_WAIT_V(8); PG8_WAIT_L(0); PG8_BAR; PG8_MMA(1, 0, At, B0); PG8_MMA(1, 1, At, B1); PG8_BAR; PG8_SCHED;
        }
        if (wr == 0) PG8_BAR;
        E(acc, cur, wr, wc, fr, fq);
        if (!has_next) break;
#pragma unroll
        for (int a = 0; a < 2; ++a)
#pragma unroll
            for (int b = 0; b < 2; ++b)
#pragma unroll
                for (int m = 0; m < 4; ++m)
#pragma unroll
                    for (int n = 0; n < 2; ++n) acc[a][b][m][n] = (f32x4){0.f, 0.f, 0.f, 0.f};
        cur = nxt; cA = nA; cB = nB; ++ui;
        if (wr == 1) PG8_BAR;
    }
    PG8_WAIT_V(0);
    PG8_BAR;
#undef PG8_SA
#undef PG8_SB
#undef PG8_STAGE
#undef PG8_LDA
#undef PG8_LDB
#undef PG8_MMA
#undef PG8_WAIT_V
#undef PG8_WAIT_L
#undef PG8_BAR
#undef PG8_SCHED
}
}

typedef f32x4 Acc[2][2][4][2];
__device__ __forceinline__ float row_rs(const float* SSQ, size_t row) {
    const f32x4 a = *(const f32x4*)(SSQ + row * 4);
    return __builtin_amdgcn_rsqf(((a.x + a.y) + (a.z + a.w)) * (1.0f / D) + RMS_EPS);
}
template <int MODE> struct EpiPair {
    static constexpr bool PERM = true;
    bf16_t* O; int ldo; const float* SSQ;
    __device__ __forceinline__ void operator()(const Acc& acc, const pg8::Unit& u, int wr, int wc, int fr, int fq) const {
        const int row0 = u.pm * 256 + wr * 64 + fr, colp = u.pn * 256 + wc * 32 + 8 * fq;
#pragma unroll
        for (int ai = 0; ai < 2; ++ai)
#pragma unroll
            for (int m = 0; m < 4; ++m) { bf16_t* rowp = O + (size_t)(row0 + ai * 128 + m * 16) * ldo;
                const float rs = MODE == 0 ? row_rs(SSQ, (size_t)(row0 + ai * 128 + m * 16)) : 1.0f;
#pragma unroll
                for (int bj = 0; bj < 2; ++bj) { const f32x4 a = acc[ai][bj][m][0] * rs, b = acc[ai][bj][m][1] * rs; float v[4];
#pragma unroll
                    for (int i = 0; i < 4; ++i) v[i] = MODE == 0 ? a[i] * sigmoidf_(a[i]) * b[i] : a[i] * sigmoidf_(b[i]);
                    u32x2 w; w.x = pg8::cvt_pk_bf16(v[0], v[1]); w.y = pg8::cvt_pk_bf16(v[2], v[3]);
                    *(u32x2*)(rowp + ((colp + bj * 128) >> 1)) = w; } }
    }
};
template <bool SRC32> struct EpiResid {
    static constexpr bool PERM = false;
    const float* hsrc; float scale; bf16_t* HB; float* SSQ; LAS float* part;
    __device__ __forceinline__ void operator()(const Acc& acc, const pg8::Unit& u, int wr, int wc, int fr, int fq) const {
        const float* sbase = hsrc + (size_t)u.pm * 256 * D;
        bf16_t* hbase = HB + (size_t)u.pm * 256 * D;
        const int rl0 = wr * 64 + fr, col0 = u.pn * 256 + wc * 32 + 4 * fq;
        unsigned off = (unsigned)(rl0 * D + col0);
        f32x4 cur[4], nxt[4]; u32x2 curb[4], nxtb[4];
#pragma unroll
        for (int q = 0; q < 4; ++q) { if (SRC32) cur[q] = *(const f32x4*)(sbase + off + (q >> 1) * 128 + (q & 1) * 16); else curb[q] = *(const u32x2*)(hbase + off + (q >> 1) * 128 + (q & 1) * 16); }
#pragma unroll
        for (int ai = 0; ai < 2; ++ai)
#pragma unroll
            for (int m = 0; m < 4; ++m) { const int rl = rl0 + ai * 128 + m * 16; float ss = 0.f;
                const unsigned offn = off + (unsigned)((m == 3 ? (128 - 48) : 16) * D);
                if (!(ai == 1 && m == 3)) {
#pragma unroll
                    for (int q = 0; q < 4; ++q) { if (SRC32) nxt[q] = *(const f32x4*)(sbase + offn + (q >> 1) * 128 + (q & 1) * 16); else nxtb[q] = *(const u32x2*)(hbase + offn + (q >> 1) * 128 + (q & 1) * 16); }
                }
#pragma unroll
                for (int bj = 0; bj < 2; ++bj)
#pragma unroll
                    for (int n = 0; n < 2; ++n) { const int q = bj * 2 + n;
                        const f32x4 old = SRC32 ? cur[q] : (f32x4){bf_lo(curb[q].x), bf_hi(curb[q].x), bf_lo(curb[q].y), bf_hi(curb[q].y)};
                        const f32x4 v = old + acc[ai][bj][m][n] * scale;
                        ss += (v.x * v.x + v.y * v.y) + (v.z * v.z + v.w * v.w);
                        u32x2 w; w.x = pg8::cvt_pk_bf16(v.x, v.y); w.y = pg8::cvt_pk_bf16(v.z, v.w); *(u32x2*)(hbase + off + bj * 128 + n * 16) = w; }
                ss += __shfl_xor(ss, 16); ss += __shfl_xor(ss, 32);
                if (fq == 0) part[rl * 4 + wc] = ss;
#pragma unroll
                for (int q = 0; q < 4; ++q) { cur[q] = nxt[q]; curb[q] = nxtb[q]; }
                off = offn;
                asm volatile("" : "+v"(off) :: "memory"); }
        asm volatile("s_waitcnt lgkmcnt(0)" ::: "memory"); __builtin_amdgcn_s_barrier(); asm volatile("" ::: "memory");
        const int tid = (wr * 4 + wc) * 64 + fq * 16 + fr;
        if (tid < 256) { const f32x4 q = *(const LAS f32x4*)(part + tid * 4); SSQ[((size_t)u.pm * 256 + tid) * 4 + u.pn] = (q.x + q.y) + (q.z + q.w); }
    }
};
struct EpiIn {
    static constexpr bool PERM = true;
    bf16_t *U, *Q, *Kb, *VT, *GATES; float* FLOG; const float* b_gate; const float* b_f; const float* SSQ;
    __device__ __forceinline__ void operator()(const Acc& acc, const pg8::Unit& u, int wr, int wc, int fr, int fq) const {
        const int row0 = u.pm * 256 + wr * 64 + fr, colt = wc * 32 + 8 * fq;
        if (u.sub == 1) {
            f32x4 rt[2][2];
#pragma unroll
            for (int bj = 0; bj < 2; ++bj)
#pragma unroll
                for (int n = 0; n < 2; ++n)
#pragma unroll
                    for (int i = 0; i < 4; ++i) rt[bj][n][i] = row_rs(SSQ, (size_t)(u.pn * 256 + colt + bj * 128 + 4 * n + i));
#pragma unroll
            for (int ai = 0; ai < 2; ++ai)
#pragma unroll
                for (int m = 0; m < 4; ++m) { bf16_t* rowp = VT + (size_t)(row0 + ai * 128 + m * 16) * T + u.pn * 256 + colt;
#pragma unroll
                    for (int bj = 0; bj < 2; ++bj) { const f32x4 v0 = acc[ai][bj][m][0] * rt[bj][0], v1 = acc[ai][bj][m][1] * rt[bj][1]; u32x4 w;
                        w.x = pg8::cvt_pk_bf16(v0[0], v0[1]); w.y = pg8::cvt_pk_bf16(v0[2], v0[3]); w.z = pg8::cvt_pk_bf16(v1[0], v1[1]); w.w = pg8::cvt_pk_bf16(v1[2], v1[3]);
                        *(u32x4*)(rowp + bj * 128) = w; } }
            return;
        }
        const int pn = u.pn;
        if (pn < 6) {
            bf16_t* base = pn < 2 ? U + pn * 256 : (pn < 4 ? Q + (pn - 2) * 256 : Kb + (pn - 4) * 256);
            const float sc = (pn == 2 || pn == 3) ? 0.125f * LOG2E : 1.0f;
#pragma unroll
            for (int ai = 0; ai < 2; ++ai)
#pragma unroll
                for (int m = 0; m < 4; ++m) { bf16_t* rowp = base + (size_t)(row0 + ai * 128 + m * 16) * 512 + colt;
                    const float rsc = sc * row_rs(SSQ, (size_t)(row0 + ai * 128 + m * 16));
#pragma unroll
                    for (int bj = 0; bj < 2; ++bj) { const f32x4 v0 = acc[ai][bj][m][0] * rsc, v1 = acc[ai][bj][m][1] * rsc; u32x4 w;
                        w.x = pg8::cvt_pk_bf16(v0[0], v0[1]); w.y = pg8::cvt_pk_bf16(v0[2], v0[3]); w.z = pg8::cvt_pk_bf16(v1[0], v1[1]); w.w = pg8::cvt_pk_bf16(v1[2], v1[3]);
                        *(u32x4*)(rowp + bj * 128) = w; } }
        } else if (pn < 14) {
            const int gc = (pn - 6) * 256 + colt;
            f32x4 bv[2][2];
#pragma unroll
            for (int bj = 0; bj < 2; ++bj)
#pragma unroll
                for (int n = 0; n < 2; ++n) bv[bj][n] = *(const f32x4*)(b_gate + gc + bj * 128 + 4 * n);
#pragma unroll
            for (int ai = 0; ai < 2; ++ai)
#pragma unroll
                for (int m = 0; m < 4; ++m) { bf16_t* rowp = GATES + (size_t)(row0 + ai * 128 + m * 16) * 2048 + gc;
                    const float rs = row_rs(SSQ, (size_t)(row0 + ai * 128 + m * 16));
#pragma unroll
                    for (int bj = 0; bj < 2; ++bj) { f32x4 v0 = acc[ai][bj][m][0] * rs + bv[bj][0], v1 = acc[ai][bj][m][1] * rs + bv[bj][1];
#pragma unroll
                        for (int i = 0; i < 4; ++i) { v0[i] = sigmoidf_(v0[i]); v1[i] = sigmoidf_(v1[i]); }
                        u32x4 w; w.x = pg8::cvt_pk_bf16(v0[0], v0[1]); w.y = pg8::cvt_pk_bf16(v0[2], v0[3]); w.z = pg8::cvt_pk_bf16(v1[0], v1[1]); w.w = pg8::cvt_pk_bf16(v1[2], v1[3]);
                        *(u32x4*)(rowp + bj * 128) = w; } }
        } else {
            if (wc == 0 && fq == 0) {
                const f32x4 b0 = *(const f32x4*)(b_f), b1 = *(const f32x4*)(b_f + 4);
#pragma unroll
                for (int ai = 0; ai < 2; ++ai)
#pragma unroll
                    for (int m = 0; m < 4; ++m) { float* rowp = FLOG + (size_t)(row0 + ai * 128 + m * 16) * 8;
                        const float rs = row_rs(SSQ, (size_t)(row0 + ai * 128 + m * 16));
                        f32x4 z0 = acc[ai][0][m][0] * rs + b0, z1 = acc[ai][0][m][1] * rs + b1;
#pragma unroll
                        for (int i = 0; i < 4; ++i) {
                            z0[i] = (fminf(z0[i], 0.f) - __logf(1.0f + __expf(-fabsf(z0[i])))) * LOG2E;
                            z1[i] = (fminf(z1[i], 0.f) - __logf(1.0f + __expf(-fabsf(z1[i])))) * LOG2E; }
                        *(f32x4*)(rowp) = z0; *(f32x4*)(rowp + 4) = z1; }
            }
        }
    }
};
template <int SECOND> struct EpiBranch {
    static constexpr bool PERM = true;
    const bf16_t* GATES; bf16_t* MERGED;
    __device__ __forceinline__ void operator()(const Acc& acc, const pg8::Unit& u, int wr, int wc, int fr, int fq) const {
        const int row0 = u.pm * 256 + wr * 64 + fr, col0 = u.pn * 256 + wc * 32 + 8 * fq;
#pragma unroll
        for (int ai = 0; ai < 2; ++ai)
#pragma unroll
            for (int m = 0; m < 4; ++m) { const size_t r = (size_t)(row0 + ai * 128 + m * 16);
#pragma unroll
                for (int bj = 0; bj < 2; ++bj) { const int c = col0 + bj * 128;
                    const u32x4 gw = *(const u32x4*)(GATES + r * 2048 + SECOND * 1024 + c);
                    const f32x4 a0 = acc[ai][bj][m][0], a1 = acc[ai][bj][m][1];
                    float v[8] = {bf_lo(gw.x) * a0[0], bf_hi(gw.x) * a0[1], bf_lo(gw.y) * a0[2], bf_hi(gw.y) * a0[3], bf_lo(gw.z) * a1[0], bf_hi(gw.z) * a1[1], bf_lo(gw.w) * a1[2], bf_hi(gw.w) * a1[3]};
                    if (SECOND) { const u32x4 pw = *(const u32x4*)(MERGED + r * 1024 + c);
                        v[0] += bf_lo(pw.x); v[1] += bf_hi(pw.x); v[2] += bf_lo(pw.y); v[3] += bf_hi(pw.y); v[4] += bf_lo(pw.z); v[5] += bf_hi(pw.z); v[6] += bf_lo(pw.w); v[7] += bf_hi(pw.w); }
                    u32x4 w; w.x = pg8::cvt_pk_bf16(v[0], v[1]); w.y = pg8::cvt_pk_bf16(v[2], v[3]); w.z = pg8::cvt_pk_bf16(v[4], v[5]); w.w = pg8::cvt_pk_bf16(v[6], v[7]);
                    *(u32x4*)(MERGED + r * 1024 + c) = w; } }
    }
};

struct EpiBranchBoth {
    static constexpr bool PERM = true;
    EpiBranch<0> e0; EpiBranch<1> e1;
    __device__ __forceinline__ void operator()(const Acc& acc, const pg8::Unit& u, int wr, int wc, int fr, int fq) const { if (u.sub == 0) e0(acc, u, wr, wc, fr, fq); else e1(acc, u, wr, wc, fr, fq); }
};

__device__ __forceinline__ void wt_item(const float* W, const float* W2, const float* gsc, int ldn, int K, int Nout, int mode, bf16_t* dst, LAS float* scr, int item, int lane) {
    const int nblk = Nout / 32, kb = item / nblk, nb = item % nblk, k0 = 64 * kb, n0 = 32 * nb;
    const int n = n0 + (lane & 31); bool zero = false; const float* src;
    { const int grp = n >> 3, w = n & 7, j = grp * 4 + (w & 3);
      if (mode == 0) src = W + n;
      else if (mode == 1) src = ((w >> 2) ? W2 : W) + j;
      else if (mode == 2) src = W + (w >> 2) * 512 + j;
      else if (mode == 3) { int col = n; if (n >= 1536) col = 2056 + (n - 1536); if (n >= 3584) col = 2048 + (n - 3584); if (n >= 3592) { col = 0; zero = true; } src = W + col; }
      else src = W + 1536 + n; }
#pragma unroll
    for (int i = 0; i < 32; ++i) { const int kk = 2 * i + (lane >> 5); scr[kk * 33 + (lane & 31)] = zero ? 0.f : src[(size_t)(k0 + kk) * ldn] * (gsc ? gsc[k0 + kk] : 1.0f); }
    __builtin_amdgcn_fence(__ATOMIC_RELEASE, "wavefront"); asm volatile("s_waitcnt lgkmcnt(0)" ::: "memory");
    const int c = lane & 7;
#pragma unroll
    for (int j = 0; j < 4; ++j) { const int nn = (lane >> 3) + 8 * j; const LAS float* s = scr + (8 * c) * 33 + nn;
        u32x4 o; o.x = pk2(s[0 * 33], s[1 * 33]); o.y = pk2(s[2 * 33], s[3 * 33]); o.z = pk2(s[4 * 33], s[5 * 33]); o.w = pk2(s[6 * 33], s[7 * 33]);
        *(u32x4*)(dst + (size_t)(n0 + nn) * K + k0 + 8 * c) = o; }
    asm volatile("s_waitcnt lgkmcnt(0)" ::: "memory");
}
__device__ __forceinline__ void convert_weights(KP Pk, LAS unsigned char* lds, int gw, int ngw, int wid, int lane) {
    LAS float* scr = (LAS float*)(lds + wid * 16384);
    for (int lm = 0; lm < 20; ++lm) {
        const int l = lm / 10, m = lm % 10;
        bf16_t* wb = (bf16_t*)(PWS + WS_W) + (size_t)l * W_LAYER;
        const float* W = nullptr; const float* W2 = nullptr; const float* gsc = nullptr; int ldn = D, K = D, Nout = D, mode = 0; size_t doff = 0;
        if (m == 0)      { W = PIN(3) + (size_t)l * D * DFF; W2 = PIN(4) + (size_t)l * D * DFF; ldn = DFF; K = D; Nout = 2 * DFF; mode = 1; doff = WO_W1; gsc = PIN(2) + l * D; }
        else if (m == 1) { W = PIN(5) + (size_t)l * DFF * D; ldn = D; K = DFF; Nout = D; mode = 0; doff = WO_W2; }
        else if (m == 2) { W = PIN(7) + (size_t)l * D * INW; ldn = INW; K = D; Nout = 3840; mode = 3; doff = WO_WIN; gsc = PIN(6) + l * D; }
        else if (m == 3) { W = PIN(7) + (size_t)l * D * INW; ldn = INW; K = D; Nout = 512; mode = 4; doff = WO_WV; gsc = PIN(6) + l * D; }
        else if (m == 4) { W = PIN(18) + (size_t)l * SW * 2 * SW; ldn = 2 * SW; K = SW; Nout = 2 * SW; mode = 2; doff = WO_GLU; }
        else if (m == 5) { W = PIN(19) + (size_t)l * SW * D; ldn = D; K = SW; Nout = D; mode = 0; doff = WO_BA; }
        else if (m == 6) { W = PIN(20) + (size_t)l * AW * D; ldn = D; K = AW; Nout = D; mode = 0; doff = WO_BB; }
        else if (m == 7) { W = PIN(21) + (size_t)l * D * D; ldn = D; K = D; Nout = D; mode = 0; doff = WO_O; }
        else if (m == 8) { W = PIN(23) + (size_t)l * D * DFF; W2 = PIN(24) + (size_t)l * D * DFF; ldn = DFF; K = D; Nout = 2 * DFF; mode = 1; doff = WO_W1B; gsc = PIN(22) + l * D; }
        else             { W = PIN(25) + (size_t)l * DFF * D; ldn = D; K = DFF; Nout = D; mode = 0; doff = WO_W2B; }
        const int items = (K / 64) * (Nout / 32);
        for (int it = gw; it < items; it += ngw) wt_item(W, W2, gsc, ldn, K, Nout, mode, wb + doff, scr, it, lane);
    }
}
template <int MODE>
__device__ __forceinline__ void norm_rows(KP Pk, const float* g, int gw, int ngw, int lane) {
    float* hmain = POUT; float* hmeta = (float*)(PWS + WS_HMETA); bf16_t* XN = (bf16_t*)(PWS + WS_XN); float* SSQ = (float*)(PWS + WS_SSQ);
    f32x4 gv[4];
#pragma unroll
    for (int j = 0; j < 4; ++j) gv[j] = MODE == 2 ? *((const f32x4*)g + lane + 64 * j) : (f32x4){1.f, 1.f, 1.f, 1.f};
    const int nrows = MODE == 2 ? TREAL : TREAL + NMETA;
#pragma unroll 2
    for (int r = gw; r < nrows; r += ngw) {
        float* hrow = r < TREAL ? hmain + (size_t)r * D : hmeta + (size_t)(r - TREAL) * D;
        const float* src = hrow;
        if (MODE == 1) src = r < TREAL ? PIN(0) + (size_t)r * D : PIN(1) + (size_t)((r - TREAL) & 15) * D;
        f32x4 v[4]; float s = 0.f;
#pragma unroll
        for (int j = 0; j < 4; ++j) {
            if (MODE == 2) { const u32x2 w = *((const u32x2*)(XN + (size_t)r * D) + lane + 64 * j); v[j] = (f32x4){bf_lo(w.x), bf_hi(w.x), bf_lo(w.y), bf_hi(w.y)}; }
            else v[j] = *((const f32x4*)src + lane + 64 * j);
            s += (v[j].x * v[j].x + v[j].y * v[j].y) + (v[j].z * v[j].z + v[j].w * v[j].w); }
        const float tot = wave_sum(s);
        if (MODE == 1) {
            unsigned long long* o8 = (unsigned long long*)(XN + (size_t)r * D) + lane;
#pragma unroll
            for (int j = 0; j < 4; ++j) { if (r >= TREAL) *((f32x4*)hrow + lane + 64 * j) = v[j]; o8[64 * j] = (unsigned long long)pk2(v[j].x, v[j].y) | ((unsigned long long)pk2(v[j].z, v[j].w) << 32); }
            if (lane < 4) SSQ[(size_t)r * 4 + lane] = lane == 0 ? tot : 0.f;
            if (r >= TREAL) ((float*)(PWS + WS_SSQM))[(r - TREAL) * 64 + lane] = lane == 0 ? tot : 0.f;
        } else {
            const float rs = 1.0f / sqrtf(tot * (1.0f / D) + RMS_EPS);
#pragma unroll
            for (int j = 0; j < 4; ++j) *((f32x4*)hrow + lane + 64 * j) = v[j] * rs * gv[j];
        }
    }
}
__device__ __forceinline__ void cumscan(KP Pk, int gw, int ngw, int lane) {
    const float* FLOG = (const float*)(PWS + WS_FLOG); float* CUM = (float*)(PWS + WS_CUM);
    for (int unit = gw; unit < NB * NH; unit += ngw) {
        const int b = unit >> 3, h = unit & 7, p0 = lane * 33;
        float vv[33];
#pragma unroll
        for (int i = 0; i < 33; ++i) { const int p = p0 + i; vv[i] = p < LPOS ? FLOG[(size_t)row_of(b, p) * 8 + h] : 0.f; }
        float run = 0.f;
#pragma unroll
        for (int i = 0; i < 33; ++i) { run += vv[i]; vv[i] = run; }
        float inc = run;
#pragma unroll
        for (int o = 1; o < 64; o <<= 1) { const float t = __shfl_up(inc, o); if (lane >= o) inc += t; }
        const float excl = inc - run;
#pragma unroll
        for (int i = 0; i < 33; ++i) { const int p = p0 + i; if (p < LPOS) CUM[(size_t)unit * LPOS + p] = excl + vv[i]; }
    }
}
__device__ __forceinline__ int seg_blk0(int s) { return s == 0 ? 0 : 1 + 32 * s; }
typedef short s16x4 __attribute__((ext_vector_type(4)));
constexpr int SSM_LDS_WAVE = 14336;
template <int PASS>
__device__ __forceinline__ void ssm_pass(KP Pk, int l, LAS unsigned char* lds, int gw, int ngw, int wid, int lane) {
    const bf16_t* U = (const bf16_t*)(PWS + WS_U); bf16_t* Y = (bf16_t*)(PWS + WS_YSSM); float* SS = (float*)(PWS + WS_SSMS);
    LAS float* bub = (LAS float*)(lds + wid * SSM_LDS_WAVE);
    LAS unsigned* hbuf = (LAS unsigned*)(lds + wid * SSM_LDS_WAVE + 9216);
    const int tq = lane & 15, jq = lane >> 4;
    for (int task = gw; task < NB * NG * NSEG; task += ngw) {
        const int unit = task / NSEG, seg = task % NSEG, b = unit / NG, g = unit % NG, p = lane;
        const float dt = __expf(PIN(12)[l * NG + g]);
        const float lre = PIN(10)[(l * NG + g) * NP + p], lim = PIN(11)[(l * NG + g) * NP + p];
        const float mag = __expf(lre * dt), ang = lim * dt;
        const float abr = mag * cosf(ang), abi = mag * sinf(ang);
        const float den = lre * lre + lim * lim, nre = abr - 1.0f;
        const float cre = (nre * lre + abi * lim) / den, cim = (abi * lre - nre * lim) / den;
        s16x4 Af[8];
#pragma unroll
        for (int nb = 0; nb < 4; ++nb) { const int pp = 16 * nb + tq; const float crs = __shfl(cre, pp), cis = __shfl(cim, pp);
            const f32x4 br = *(const f32x4*)(PIN(13) + ((size_t)(l * NG + g) * NP + pp) * NC + 4 * jq), bi = *(const f32x4*)(PIN(14) + ((size_t)(l * NG + g) * NP + pp) * NC + 4 * jq);
            s16x4 fr_, fi_;
#pragma unroll
            for (int i = 0; i < 4; ++i) { fr_[i] = (short)f2bf(crs * br[i] - cis * bi[i]); fi_[i] = (short)f2bf(crs * bi[i] + cis * br[i]); }
            Af[nb * 2] = fr_; Af[nb * 2 + 1] = fi_; }
        float hr = 0.f, hi = 0.f;
        const int blk0 = seg_blk0(seg), blk1 = seg_blk0(seg + 1);
        bf16x8 Cf[4]; float dsk = 0.f;
        if (PASS == 1) {
            float a16r = abr, a16i = abi;
#pragma unroll
            for (int i = 0; i < 4; ++i) { const float r2 = a16r * a16r - a16i * a16i, i2 = 2.f * a16r * a16i; a16r = r2; a16i = i2; }
            for (int s = 0; s < seg; ++s) {
                const int nb = seg_blk0(s + 1) - seg_blk0(s); float pr = 1.f, pi = 0.f;
                for (int i = 0; i < nb; ++i) { const float r2 = pr * a16r - pi * a16i, i2 = pr * a16i + pi * a16r; pr = r2; pi = i2; }
                const float sr = SS[((size_t)unit * NSEG + s) * 128 + p], si = SS[((size_t)unit * NSEG + s) * 128 + 64 + p];
                const float r2 = pr * hr - pi * hi + sr, i2 = pr * hi + pi * hr + si; hr = r2; hi = i2;
            }
#pragma unroll
            for (int kk = 0; kk < 4; ++kk) { bf16x8 f;
#pragma unroll
                for (int i = 0; i < 8; ++i) { const int k = kk * 32 + jq * 8 + i, st = k >> 1;
                    const float v = (k & 1) ? -PIN(16)[((size_t)(l * NG + g) * NC + tq) * NP + st] : PIN(15)[((size_t)(l * NG + g) * NC + tq) * NP + st];
                    f[i] = (short)f2bf(v); }
                Cf[kk] = f; }
            dsk = PIN(17)[l * SW + g * NC + tq];
        }
#define SSM_RBASE(blk_) ((blk_) == 0 ? TREAL : b * SEQ + ((blk_) - 1) * 16)
#define SSM_LOADU(dst, dstu, blk_) do { const int rb_ = SSM_RBASE(blk_); dst = *(const u32x2*)(U + (size_t)(rb_ + tq) * SW + g * NC + 4 * jq); \
            if (PASS == 1) { _Pragma("unroll") for (int r = 0; r < 4; ++r) dstu[r] = U[(size_t)(rb_ + 4 * jq + r) * SW + g * NC + tq]; } } while (0)
        u32x2 uq[4], un[4]; bf16_t uvq[4][4], uvn[4][4];
#pragma unroll
        for (int k = 0; k < 4; ++k) { un[k] = (u32x2){0u, 0u};
#pragma unroll
            for (int r = 0; r < 4; ++r) uvn[k][r] = 0; }
#define SSM_BLOCK(UQ, UVQ, blk_) do { const int blkx = (blk_); const int rbase = SSM_RBASE(blkx); \
            const s16x4 ub = __builtin_bit_cast(s16x4, UQ); \
            _Pragma("unroll") for (int f = 0; f < 8; ++f) { f32x4 d = {0.f, 0.f, 0.f, 0.f}; d = __builtin_amdgcn_mfma_f32_16x16x16bf16_1k(Af[f], ub, d, 0, 0, 0); \
                _Pragma("unroll") for (int r = 0; r < 4; ++r) bub[(16 * (f >> 1) + 4 * jq + r) * 36 + (f & 1) * 16 + tq] = d[r]; } \
            __builtin_amdgcn_fence(__ATOMIC_RELEASE, "wavefront"); asm volatile("s_waitcnt lgkmcnt(0)" ::: "memory"); \
            f32x4 bre[4], bim[4]; \
            _Pragma("unroll") for (int q = 0; q < 4; ++q) { bre[q] = *(const LAS f32x4*)(bub + p * 36 + q * 4); bim[q] = *(const LAS f32x4*)(bub + p * 36 + 16 + q * 4); } \
            _Pragma("unroll") for (int t = 0; t < 16; ++t) { \
                const float r2 = abr * hr - abi * hi + bre[t >> 2][t & 3], i2 = abr * hi + abi * hr + bim[t >> 2][t & 3]; hr = r2; hi = i2; \
                if (PASS == 1) hbuf[t * 68 + p] = pg8::cvt_pk_bf16(hr, hi); } \
            if (PASS == 1) { \
                __builtin_amdgcn_fence(__ATOMIC_RELEASE, "wavefront"); asm volatile("s_waitcnt lgkmcnt(0)" ::: "memory"); \
                f32x4 acc = {0.f, 0.f, 0.f, 0.f}; \
                _Pragma("unroll") for (int kk = 0; kk < 4; ++kk) { const bf16x8 a = *(const LAS bf16x8*)((LAS bf16_t*)hbuf + tq * 136 + kk * 32 + jq * 8); acc = __builtin_amdgcn_mfma_f32_16x16x32_bf16(a, Cf[kk], acc, 0, 0, 0); } \
                _Pragma("unroll") for (int r = 0; r < 4; ++r) { const int t = jq * 4 + r; const size_t off = (size_t)(rbase + t) * SW + g * NC + tq; \
                    const float uv = bf_lo((unsigned)UVQ[r]); const float y = acc[r] + dsk * uv; \
                    const float z = 1.5957691216f * (y + 0.044715f * y * y * y); \
                    if (blkx > 0 || b == 0) Y[off] = (bf16_t)f2bf(y * sigmoidf_(z)); } } \
            asm volatile("s_waitcnt lgkmcnt(0)" ::: "memory"); __builtin_amdgcn_fence(__ATOMIC_RELEASE, "wavefront"); } while (0)
        int gb0 = blk0;
        if (seg == 0) { SSM_LOADU(uq[0], uvq[0], 0); SSM_BLOCK(uq[0], uvq[0], 0); gb0 = 1; }
#pragma unroll
        for (int k = 0; k < 4; ++k) SSM_LOADU(uq[k], uvq[k], gb0 + k);
        for (int gb = gb0; gb < blk1; gb += 4) {
#pragma unroll
            for (int k = 0; k < 4; ++k) { const int nb_ = gb + 4 + k < 129 ? gb + 4 + k : 128; SSM_LOADU(un[k], uvn[k], nb_); }
            SSM_BLOCK(uq[0], uvq[0], gb); SSM_BLOCK(uq[1], uvq[1], gb + 1); SSM_BLOCK(uq[2], uvq[2], gb + 2); SSM_BLOCK(uq[3], uvq[3], gb + 3);
#pragma unroll
            for (int k = 0; k < 4; ++k) { uq[k] = un[k];
#pragma unroll
                for (int r = 0; r < 4; ++r) uvq[k][r] = uvn[k][r]; }
        }
#undef SSM_BLOCK
        if (PASS == 0) { SS[((size_t)unit * NSEG + seg) * 128 + p] = hr; SS[((size_t)unit * NSEG + seg) * 128 + 64 + p] = hi; }
    }
}
__device__ __forceinline__ float row_norm2_64(const bf16_t* p) {
    float s = 0.f;
#pragma unroll
    for (int i = 0; i < 8; ++i) { const u32x4 w = *(const u32x4*)(p + 8 * i);
        s += bf_lo(w.x) * bf_lo(w.x) + bf_hi(w.x) * bf_hi(w.x) + bf_lo(w.y) * bf_lo(w.y) + bf_hi(w.y) * bf_hi(w.y) + bf_lo(w.z) * bf_lo(w.z) + bf_hi(w.z) * bf_hi(w.z) + bf_lo(w.w) * bf_lo(w.w) + bf_hi(w.w) * bf_hi(w.w); }
    return s;
}
__device__ __forceinline__ float wave_max(float v) {
#pragma unroll
    for (int o = 1; o < 64; o <<= 1) v = fmaxf(v, __shfl_xor(v, o));
    return v;
}
__device__ __forceinline__ float sumsq8(u32x4 w) {
    return bf_lo(w.x) * bf_lo(w.x) + bf_hi(w.x) * bf_hi(w.x) + bf_lo(w.y) * bf_lo(w.y) + bf_hi(w.y) * bf_hi(w.y) + bf_lo(w.z) * bf_lo(w.z) + bf_hi(w.z) * bf_hi(w.z) + bf_lo(w.w) * bf_lo(w.w) + bf_hi(w.w) * bf_hi(w.w);
}
__device__ __forceinline__ void attn_norms(KP Pk, int gw, int ngw, int lane) {
    const bf16_t* Q = (const bf16_t*)(PWS + WS_Q); const bf16_t* Kg = (const bf16_t*)(PWS + WS_K); float* KMAX = (float*)(PWS + WS_KMAX); float* QMAX = (float*)(PWS + WS_QMAX);
    const int rsub = lane >> 3, piece = lane & 7;
    for (int task = gw; task < 128 * 32; task += ngw) {
        const int bh = task >> 5, t5 = task & 31, tile = t5 + 1, b = bh >> 3, h = bh & 7;
        const size_t base = (size_t)(b * SEQ + 64 * t5 + rsub) * AW + h * HD + piece * 8;
        u32x4 wk[8], wq[8];
#pragma unroll
        for (int i = 0; i < 8; ++i) { wk[i] = *(const u32x4*)(Kg + base + (size_t)(8 * i) * AW); wq[i] = *(const u32x4*)(Q + base + (size_t)(8 * i) * AW); }
        u32x4 wm = {0u, 0u, 0u, 0u}; u32x4 wm2 = {0u, 0u, 0u, 0u};
        if (t5 == 0) { wm = *(const u32x4*)(Kg + (size_t)(TREAL + rsub) * AW + h * HD + piece * 8); wm2 = *(const u32x4*)(Kg + (size_t)(TREAL + 8 + rsub) * AW + h * HD + piece * 8); }
        float mk = 0.f, mq = 0.f;
#pragma unroll
        for (int i = 0; i < 8; ++i) { float sk = sumsq8(wk[i]), sq = sumsq8(wq[i]);
            sk += __shfl_xor(sk, 1); sq += __shfl_xor(sq, 1); sk += __shfl_xor(sk, 2); sq += __shfl_xor(sq, 2); sk += __shfl_xor(sk, 4); sq += __shfl_xor(sq, 4);
            mk = fmaxf(mk, sk); mq = fmaxf(mq, sq); }
        float mm = 0.f;
        if (t5 == 0) { float s0 = sumsq8(wm), s1 = sumsq8(wm2); s0 += __shfl_xor(s0, 1); s1 += __shfl_xor(s1, 1); s0 += __shfl_xor(s0, 2); s1 += __shfl_xor(s1, 2); s0 += __shfl_xor(s0, 4); s1 += __shfl_xor(s1, 4); mm = fmaxf(s0, s1); }
#pragma unroll
        for (int o = 8; o < 64; o <<= 1) { mk = fmaxf(mk, __shfl_xor(mk, o)); mq = fmaxf(mq, __shfl_xor(mq, o)); mm = fmaxf(mm, __shfl_xor(mm, o)); }
        if (lane == 0) { KMAX[bh * 64 + tile] = sqrtf(mk) * 1.001f; QMAX[bh * 64 + tile] = sqrtf(mq) * 1.001f; if (t5 == 0) { KMAX[bh * 64] = sqrtf(mm) * 1.001f; QMAX[bh * 64] = 0.f; } }
    }
}
__device__ __forceinline__ void attn_phase(KP Pk, LAS unsigned char* lds, int G, int c, int tid, int wid, int lane) {
    const bf16_t* Q = (const bf16_t*)(PWS + WS_Q); const bf16_t* Kg = (const bf16_t*)(PWS + WS_K); const bf16_t* VT = (const bf16_t*)(PWS + WS_VT);
    bf16_t* YB = (bf16_t*)(PWS + WS_YB); const float* CUM = (const float*)(PWS + WS_CUM);
    LAS unsigned char* Kl = lds; LAS unsigned char* Vl = lds + 9216;
    const int ql = lane & 15, j = lane >> 4;
    for (int u = c; u < 1024 + NH; u += G) {
        const bool tb = u >= 1024;
        int bh, qt = 0, ntile;
        if (!tb) { const int i_ = u >> 8, cc = u & 255, hh = (i_ << 1) | (cc & 1), bb = cc >> 4, qq = (cc >> 1) & 7; bh = bb * 8 + hh; qt = (i_ & 1) ? 7 - qq : qq; ntile = 4 * qt + 5; } else { bh = u - 1024; ntile = 1; }
        const int b = bh >> 3, h = bh & 7;
        const bool active = tb ? (wid == 0) : true;
        int qpos[2], qrow[2]; float cumq[2]; bf16x8 qf[2][2];
#pragma unroll
        for (int gq = 0; gq < 2; ++gq) { qpos[gq] = tb ? ql : 16 + 256 * qt + 32 * wid + 16 * gq + ql; qrow[gq] = tb ? TREAL + ql : b * SEQ + qpos[gq] - 16;
            qf[gq][0] = *(const bf16x8*)(Q + (size_t)qrow[gq] * AW + h * HD + j * 8); qf[gq][1] = *(const bf16x8*)(Q + (size_t)qrow[gq] * AW + h * HD + 32 + j * 8);
            cumq[gq] = CUM[(size_t)bh * LPOS + qpos[gq]]; }
        const int wmax = tb ? 15 : 16 + 256 * qt + 32 * wid + 31, wmin = tb ? 0 : 16 + 256 * qt + 32 * wid;
        float m_run[2] = {-1e30f, -1e30f}, l_run[2] = {0.f, 0.f}; f32x4 O[2][4];
#pragma unroll
        for (int gq = 0; gq < 2; ++gq)
#pragma unroll
            for (int i = 0; i < 4; ++i) O[gq][i] = (f32x4){0.f, 0.f, 0.f, 0.f};
        const int skey = tid >> 3, spiece = tid & 7;
        u32x4 kreg, vreg; f32x4 ckn[2][2], ckc[2][2];
#define ATT_LOAD(kt_) do { const int kt__ = (kt_); \
            const bool valid = kt__ > 0 || skey < 16; const int grow = kt__ == 0 ? TREAL + (skey & 15) : b * SEQ + 64 * (kt__ - 1) + skey; \
            kreg = (u32x4){0u, 0u, 0u, 0u}; if (valid) kreg = *(const u32x4*)(Kg + (size_t)grow * AW + h * HD + spiece * 8); \
            const bool validp = kt__ > 0 || spiece < 2; const int gcol = kt__ == 0 ? TREAL + (spiece & 1) * 8 : b * SEQ + 64 * (kt__ - 1) + spiece * 8; \
            vreg = (u32x4){0u, 0u, 0u, 0u}; if (validp) vreg = *(const u32x4*)(VT + (size_t)(h * HD + skey) * T + gcol); \
            const int kp0__ = kt__ == 0 ? 0 : 16 + 64 * (kt__ - 1); \
            _Pragma("unroll") for (int g32 = 0; g32 < 2; ++g32) { const int kb = 32 * g32 + 8 * j; ckn[g32][0] = (f32x4){0.f, 0.f, 0.f, 0.f}; ckn[g32][1] = (f32x4){0.f, 0.f, 0.f, 0.f}; \
                if (kt__ > 0 || kb < 16) { const f32x4* cp = (const f32x4*)(CUM + (size_t)bh * LPOS + kp0__ + kb); ckn[g32][0] = cp[0]; ckn[g32][1] = cp[1]; } } } while (0)
        int jstart = 0;
        if (!tb) { const float* KMAX = (const float*)(PWS + WS_KMAX) + bh * 64; const float* QMAX = (const float*)(PWS + WS_QMAX) + bh * 64;
            const float qmax = fmaxf(fmaxf(QMAX[4 * qt + 1], QMAX[4 * qt + 2]), fmaxf(QMAX[4 * qt + 3], QMAX[4 * qt + 4]));
            const float kself = fmaxf(fmaxf(KMAX[4 * qt + 1], KMAX[4 * qt + 2]), fmaxf(KMAX[4 * qt + 3], KMAX[4 * qt + 4])); const float cum0 = CUM[(size_t)bh * LPOS + 16 + 256 * qt];
            const bool cand = lane <= 4 * qt; float kp = cand ? KMAX[lane] : 0.f;
#pragma unroll
            for (int o = 1; o < 64; o <<= 1) { const float t_ = __shfl_up(kp, o); if (lane >= o) kp = fmaxf(kp, t_); }
            const float kend = cand ? CUM[(size_t)bh * LPOS + 64 * lane + 15] : 0.f;
            const bool skip = cand && (qmax * (kp + kself) + cum0 - kend <= -36.0f);
            jstart = __popcll(__ballot(skip)); }
        ATT_LOAD(jstart);
        for (int kt = jstart; kt < ntile; ++kt) {
            __syncthreads();
            *(LAS u32x4*)(Kl + skey * 144 + spiece * 16) = kreg;
            *(LAS u32x4*)(Vl + skey * 144 + spiece * 16) = vreg;
#pragma unroll
            for (int g32 = 0; g32 < 2; ++g32) { ckc[g32][0] = ckn[g32][0]; ckc[g32][1] = ckn[g32][1]; }
            __syncthreads();
            if (kt + 1 < ntile) ATT_LOAD(kt + 1);
            const int kpos0 = kt == 0 ? 0 : 16 + 64 * (kt - 1);
            if (active && kpos0 <= wmax) {
                f32x4 s[2][2][2];
#pragma unroll
                for (int g32 = 0; g32 < 2; ++g32)
#pragma unroll
                    for (int blk = 0; blk < 2; ++blk) { const int key = 32 * g32 + 8 * (ql >> 2) + 4 * blk + (ql & 3);
                        const bf16x8 kf0 = *(const LAS bf16x8*)(Kl + key * 144 + j * 16), kf1 = *(const LAS bf16x8*)(Kl + key * 144 + 64 + j * 16);
#pragma unroll
                        for (int gq = 0; gq < 2; ++gq) { f32x4 a = {0.f, 0.f, 0.f, 0.f};
                            a = __builtin_amdgcn_mfma_f32_16x16x32_bf16(kf0, qf[gq][0], a, 0, 0, 0); a = __builtin_amdgcn_mfma_f32_16x16x32_bf16(kf1, qf[gq][1], a, 0, 0, 0); s[gq][g32][blk] = a; } }
                const bool need_mask = kt == 0 || kpos0 + 63 > wmin;
                bf16x8 pf[2][2]; float alpha[2];
#pragma unroll
                for (int gq = 0; gq < 2; ++gq) {
                    float tmax = -1e30f;
                    if (need_mask) {
#pragma unroll
                        for (int g32 = 0; g32 < 2; ++g32) { const int kb = 32 * g32 + 8 * j;
#pragma unroll
                            for (int blk = 0; blk < 2; ++blk)
#pragma unroll
                                for (int r = 0; r < 4; ++r) { const int key = kb + 4 * blk + r, kpos = kpos0 + key; const bool valid = kpos <= qpos[gq] && (kt > 0 || key < 16);
                                    const float v = s[gq][g32][blk][r] + (cumq[gq] - ckc[g32][blk][r]); const float sv = valid ? v : -1e30f; s[gq][g32][blk][r] = sv; tmax = fmaxf(tmax, sv); } }
                    } else {
#pragma unroll
                        for (int g32 = 0; g32 < 2; ++g32)
#pragma unroll
                            for (int blk = 0; blk < 2; ++blk)
#pragma unroll
                                for (int r = 0; r < 4; ++r) { const float v = s[gq][g32][blk][r] + (cumq[gq] - ckc[g32][blk][r]); s[gq][g32][blk][r] = v; tmax = fmaxf(tmax, v); }
                    }
                    tmax = fmaxf(tmax, __shfl_xor(tmax, 16)); tmax = fmaxf(tmax, __shfl_xor(tmax, 32));
                    const float m_new = fmaxf(m_run[gq], tmax); alpha[gq] = fast_exp2(m_run[gq] - m_new); m_run[gq] = m_new;
                    float ps = 0.f;
#pragma unroll
                    for (int g32 = 0; g32 < 2; ++g32) { float pv[8];
#pragma unroll
                        for (int blk = 0; blk < 2; ++blk)
#pragma unroll
                            for (int r = 0; r < 4; ++r) { const float e = fast_exp2(s[gq][g32][blk][r] - m_new); pv[blk * 4 + r] = e; ps += e; }
                        u32x4 w; w.x = pg8::cvt_pk_bf16(pv[0], pv[1]); w.y = pg8::cvt_pk_bf16(pv[2], pv[3]); w.z = pg8::cvt_pk_bf16(pv[4], pv[5]); w.w = pg8::cvt_pk_bf16(pv[6], pv[7]);
                        pf[gq][g32] = __builtin_bit_cast(bf16x8, w); }
                    l_run[gq] = l_run[gq] * alpha[gq] + ps;
                }
#pragma unroll
                for (int db = 0; db < 4; ++db) {
#pragma unroll
                    for (int gq = 0; gq < 2; ++gq) O[gq][db] = O[gq][db] * alpha[gq];
#pragma unroll
                    for (int g32 = 0; g32 < 2; ++g32) { const bf16x8 vf = *(const LAS bf16x8*)(Vl + (16 * db + ql) * 144 + (32 * g32 + 8 * j) * 2);
#pragma unroll
                        for (int gq = 0; gq < 2; ++gq) O[gq][db] = __builtin_amdgcn_mfma_f32_16x16x32_bf16(vf, pf[gq][g32], O[gq][db], 0, 0, 0); } }
            }
        }
        if (active) {
#pragma unroll
            for (int gq = 0; gq < 2; ++gq) { if (tb && gq == 1) break;
                float lt = l_run[gq]; lt += __shfl_xor(lt, 16); lt += __shfl_xor(lt, 32);
                const float inv = 1.0f / lt;
#pragma unroll
                for (int db = 0; db < 4; ++db) { u32x2 w; w.x = pg8::cvt_pk_bf16(O[gq][db][0] * inv, O[gq][db][1] * inv); w.y = pg8::cvt_pk_bf16(O[gq][db][2] * inv, O[gq][db][3] * inv);
                    *(u32x2*)(YB + (size_t)qrow[gq] * AW + h * HD + 16 * db + 4 * j) = w; } }
        }
    }
    __syncthreads();
}


__device__ __forceinline__ f32x4 skinny_dot(const bf16_t* A, const bf16_t* W, int K, int len, int lane) {
    const bf16_t* ap = A + (size_t)(lane & 15) * K + 8 * (lane >> 4); const bf16_t* wp = W + (size_t)(lane & 15) * K + 8 * (lane >> 4);
    f32x4 acc = {0.f, 0.f, 0.f, 0.f};
#pragma unroll 4
    for (int k0 = 0; k0 < len; k0 += 32) { const bf16x8 wf = *(const bf16x8*)(wp + k0), af = *(const bf16x8*)(ap + k0); acc = __builtin_amdgcn_mfma_f32_16x16x32_bf16(wf, af, acc, 0, 0, 0); }
    return acc;
}
__device__ __forceinline__ f32x4 skinny_dot_wg(const bf16_t* A, const bf16_t* W, int K, LAS f32x4* red, int wid, int lane) {
    const int ks = K >> 3;
    red[wid * 64 + lane] = skinny_dot(A + wid * ks, W + wid * ks, K, ks, lane);
    __syncthreads();
    f32x4 t = {0.f, 0.f, 0.f, 0.f};
    if (wid == 0) {
#pragma unroll
        for (int w = 0; w < 8; ++w) t = t + red[w * 64 + lane]; }
    __syncthreads();
    return t;
}
__device__ __forceinline__ float meta_rs(const float* SSQM, int m) {
    const f32x4* p = (const f32x4*)(SSQM + m * 64); float s = 0.f;
#pragma unroll
    for (int i = 0; i < 16; ++i) { const f32x4 a = p[i]; s += (a.x + a.y) + (a.z + a.w); }
    return __builtin_amdgcn_rsqf(s * (1.0f / D) + RMS_EPS);
}
#define SKINNY_ARGS LAS f32x4* red, int c, int G, int wid, int lane
template <int MODE>
__device__ __forceinline__ void skinny_pair(const bf16_t* A, const bf16_t* W, int N, int K, bf16_t* O, int ldo, const float* SSQM, SKINNY_ARGS) {
    const int m = lane & 15, j = lane >> 4;
    for (int tg = c; tg < N / 16; tg += G) {
        f32x4 a = skinny_dot_wg(A + (size_t)TREAL * K, W + (size_t)tg * 16 * K, K, red, wid, lane);
        if (wid == 0) {
            if (MODE == 0) a = a * meta_rs(SSQM, m);
            f32x4 b;
#pragma unroll
            for (int i = 0; i < 4; ++i) b[i] = __shfl_xor(a[i], 16);
            if ((j & 1) == 0) { float v[4];
#pragma unroll
                for (int i = 0; i < 4; ++i) v[i] = MODE == 0 ? a[i] * sigmoidf_(a[i]) * b[i] : a[i] * sigmoidf_(b[i]);
                u32x2 w; w.x = pg8::cvt_pk_bf16(v[0], v[1]); w.y = pg8::cvt_pk_bf16(v[2], v[3]);
                *(u32x2*)(O + (size_t)(TREAL + m) * ldo + tg * 8 + 2 * j) = w; }
        }
    }
}
__device__ __forceinline__ void skinny_resid(const bf16_t* A, const bf16_t* W, int K, float scale, float* hmeta, bf16_t* HB, float* SSQM, SKINNY_ARGS) {
    const int m = lane & 15, j = lane >> 4;
    for (int tg = c; tg < D / 16; tg += G) { const int n0 = tg * 16;
        const f32x4 acc = skinny_dot_wg(A + (size_t)TREAL * K, W + (size_t)n0 * K, K, red, wid, lane);
        if (wid == 0) {
            f32x4* hp = (f32x4*)(hmeta + (size_t)m * D + n0 + 4 * j); f32x4 v = *hp; v = v + acc * scale; *hp = v;
            float ss = (v.x * v.x + v.y * v.y) + (v.z * v.z + v.w * v.w);
            u32x2 w; w.x = pg8::cvt_pk_bf16(v.x, v.y); w.y = pg8::cvt_pk_bf16(v.z, v.w); *(u32x2*)(HB + (size_t)(TREAL + m) * D + n0 + 4 * j) = w;
            ss += __shfl_xor(ss, 16); ss += __shfl_xor(ss, 32);
            if (j == 0) SSQM[m * 64 + tg] = ss;
        }
    }
}
__device__ __forceinline__ void skinny_in(const bf16_t* A, const bf16_t* WIN, const bf16_t* WV, bf16_t* U, bf16_t* Q, bf16_t* Kb, bf16_t* VT, bf16_t* GATES, float* FLOG,
                                          const float* b_gate, const float* b_f, const float* SSQM, SKINNY_ARGS) {
    const int m = lane & 15, j = lane >> 4;
    for (int tg = c; tg < 225 + 32; tg += G) {
        const bool isv = tg >= 225; const int n0 = isv ? (tg - 225) * 16 : tg * 16;
        f32x4 a = skinny_dot_wg(A + (size_t)TREAL * D, (isv ? WV : WIN) + (size_t)n0 * D, D, red, wid, lane);
        if (wid == 0) {
            a = a * meta_rs(SSQM, m);
            const int c0 = n0 + 4 * j;
            if (isv) {
#pragma unroll
                for (int r = 0; r < 4; ++r) VT[(size_t)(c0 + r) * T + TREAL + m] = (bf16_t)f2bf(a[r]);
            } else if (n0 < 1536) {
                bf16_t* base = n0 < 512 ? U + c0 : (n0 < 1024 ? Q + (c0 - 512) : Kb + (c0 - 1024));
                if (n0 >= 512 && n0 < 1024) a = a * (0.125f * LOG2E);
                u32x2 w; w.x = pg8::cvt_pk_bf16(a[0], a[1]); w.y = pg8::cvt_pk_bf16(a[2], a[3]); *(u32x2*)(base + (size_t)(TREAL + m) * 512) = w;
            } else if (n0 < 3584) {
                const int gc = c0 - 1536; const f32x4 bv = *(const f32x4*)(b_gate + gc); float v[4];
#pragma unroll
                for (int i = 0; i < 4; ++i) v[i] = sigmoidf_(a[i] + bv[i]);
                u32x2 w; w.x = pg8::cvt_pk_bf16(v[0], v[1]); w.y = pg8::cvt_pk_bf16(v[2], v[3]); *(u32x2*)(GATES + (size_t)(TREAL + m) * 2048 + gc) = w;
            } else if (j < 2) {
                const f32x4 bv = *(const f32x4*)(b_f + 4 * j); f32x4 z = a + bv;
#pragma unroll
                for (int i = 0; i < 4; ++i) z[i] = (fminf(z[i], 0.f) - __logf(1.0f + __expf(-fabsf(z[i])))) * LOG2E;
                *(f32x4*)(FLOG + (size_t)(TREAL + m) * 8 + 4 * j) = z;
            }
        }
    }
}
__device__ __forceinline__ void f_rows(const bf16_t* A, const bf16_t* WF, float* FLOG, const float* b_f, const float* SSQ, int gw, int ngw, int lane) {
    const int m = lane & 15, j = lane >> 4;
    for (int grp = gw; grp < TREAL / 16; grp += ngw) { const int r0 = grp * 16;
        const bf16_t* ap = A + (size_t)(r0 + m) * D + 8 * j; const bf16_t* wp = WF + (size_t)m * D + 8 * j;
        f32x4 acc = {0.f, 0.f, 0.f, 0.f};
#pragma unroll 8
        for (int k0 = 0; k0 < D; k0 += 32) { const bf16x8 wf = *(const bf16x8*)(wp + k0), af = *(const bf16x8*)(ap + k0); acc = __builtin_amdgcn_mfma_f32_16x16x32_bf16(wf, af, acc, 0, 0, 0); }
        if (j < 2) { const f32x4 bv = *(const f32x4*)(b_f + 4 * j); f32x4 z = acc * row_rs(SSQ, (size_t)(r0 + m)) + bv;
#pragma unroll
            for (int i = 0; i < 4; ++i) z[i] = (fminf(z[i], 0.f) - __logf(1.0f + __expf(-fabsf(z[i])))) * LOG2E;
            *(f32x4*)(FLOG + (size_t)(r0 + m) * 8 + 4 * j) = z; }
    }
}
__device__ __forceinline__ void skinny_branch(const bf16_t* YA, const bf16_t* YB, const bf16_t* WA, const bf16_t* WB, const bf16_t* GATES, bf16_t* MERGED, SKINNY_ARGS) {
    const int m = lane & 15, j = lane >> 4;
    for (int tg = c; tg < D / 16; tg += G) { const int c0 = tg * 16 + 4 * j;
        const f32x4 a = skinny_dot_wg(YA + (size_t)TREAL * SW, WA + (size_t)tg * 16 * SW, SW, red, wid, lane), b = skinny_dot_wg(YB + (size_t)TREAL * AW, WB + (size_t)tg * 16 * AW, AW, red, wid, lane);
        if (wid == 0) {
            const u32x2 ga = *(const u32x2*)(GATES + (size_t)(TREAL + m) * 2048 + c0), gb = *(const u32x2*)(GATES + (size_t)(TREAL + m) * 2048 + 1024 + c0);
            const float v0 = bf_lo(ga.x) * a[0] + bf_lo(gb.x) * b[0], v1 = bf_hi(ga.x) * a[1] + bf_hi(gb.x) * b[1], v2 = bf_lo(ga.y) * a[2] + bf_lo(gb.y) * b[2], v3 = bf_hi(ga.y) * a[3] + bf_hi(gb.y) * b[3];
            u32x2 w; w.x = pg8::cvt_pk_bf16(v0, v1); w.y = pg8::cvt_pk_bf16(v2, v3); *(u32x2*)(MERGED + (size_t)(TREAL + m) * D + c0) = w; }
    }
}

#define XB_TMO      128
#define XB_XCNT(j)  (256  + 64 * (j))
#define XB_XSUB(j)  (1280 + 64 * (j))
#define XB_XGEN(j)  (2304 + 64 * (j))
#define XB_TOP      3328
#define XB_TOPGEN   3392
#define XCD_BAR_WORDS 3456
#define XB_SPIN_CAP (1u << 20)
__device__ __forceinline__ unsigned xb_ld(unsigned* p)              { return __hip_atomic_load(p, __ATOMIC_RELAXED, __HIP_MEMORY_SCOPE_AGENT); }
__device__ __forceinline__ unsigned xb_add(unsigned* p, unsigned v) { return __hip_atomic_fetch_add(p, v, __ATOMIC_RELAXED, __HIP_MEMORY_SCOPE_AGENT); }
__device__ __forceinline__ unsigned xb_xcc_id() { return (unsigned)__builtin_amdgcn_s_getreg((3 << 11) | 20) & 0xFu; }
#define XB_SPIN(cond, bar) do { unsigned _sp = 0; while (cond) { __builtin_amdgcn_s_sleep(1); \
    if ((++_sp & 255u) == 0u) { if (xb_ld(&(bar)[XB_TMO])) break; if (_sp > XB_SPIN_CAP) { atomicAdd(&(bar)[XB_TMO], 1u); break; } } } } while (0)
struct XcdBarrier { unsigned* bar; unsigned x; volatile LAS unsigned* st; };
__device__ __forceinline__ XcdBarrier xcd_barrier_post(unsigned* bar, volatile LAS unsigned* st) {
    XcdBarrier b; b.bar = bar; b.x = xb_xcc_id(); b.st = st;
    if (threadIdx.x == 0) (void)xb_add(&bar[XB_XCNT(b.x)], 1u);
    return b;
}
__device__ __forceinline__ void xcd_barrier_complete(unsigned* bar, unsigned x, unsigned& nloc, unsigned& nx) {
    const unsigned G = gridDim.x * gridDim.y * gridDim.z;
    unsigned sum, cnt, mine, sp = 0u;
    for (;;) {
        sum = 0u; cnt = 0u; mine = 0u;
#pragma unroll
        for (unsigned j = 0; j < 16; ++j) { const unsigned c = xb_ld(&bar[XB_XCNT(j)]); sum += c; cnt += (c > 0u) ? 1u : 0u; mine = (j == x) ? c : mine; }
        if (sum == G) break;
        __builtin_amdgcn_s_sleep(1);
        if ((++sp & 255u) == 0u) { if (xb_ld(&bar[XB_TMO])) break; if (sp > XB_SPIN_CAP) { atomicAdd(&bar[XB_TMO], 1u); break; } }
    }
    nloc = mine > 0u ? mine : 1u; nx = cnt > 0u ? cnt : 1u;
}
__device__ __forceinline__ void xcd_barrier(const XcdBarrier& b) {
    asm volatile("s_waitcnt vmcnt(0)" ::: "memory");
    __syncthreads();
    if (threadIdx.x == 0) {
        unsigned* bar = b.bar;
        __builtin_amdgcn_s_waitcnt(0);
        unsigned nloc = b.st[0], nx = b.st[1];
        if (nloc == 0u) { xcd_barrier_complete(bar, b.x, nloc, nx); b.st[0] = nloc; b.st[1] = nx; }
        const unsigned old = xb_add(&bar[XB_XSUB(b.x)], 1u);
        const unsigned gen = old / nloc;
        if (old + 1u == (gen + 1u) * nloc) {
            __builtin_amdgcn_fence(__ATOMIC_RELEASE, "agent");
            asm volatile("s_waitcnt vmcnt(0)" ::: "memory");
            const unsigned og = xb_add(&bar[XB_TOP], 1u);
            const unsigned tg = og / nx;
            if (og + 1u == (tg + 1u) * nx) xb_add(&bar[XB_TOPGEN], 1u);
            else XB_SPIN(xb_ld(&bar[XB_TOPGEN]) == tg, bar);
            __builtin_amdgcn_fence(__ATOMIC_ACQUIRE, "agent");
            xb_add(&bar[XB_XGEN(b.x)], 1u);
            asm volatile("s_waitcnt vmcnt(0)" ::: "memory");
        } else {
            XB_SPIN(xb_ld(&bar[XB_XGEN(b.x)]) == gen, bar);
            __builtin_amdgcn_fence(__ATOMIC_ACQUIRE, "agent");
            asm volatile("s_waitcnt vmcnt(0)" ::: "memory");
        }
    }
    __syncthreads();
}

constexpr int NPH = 22;
constexpr int LDS_BYTES = 147456;
__global__ void __launch_bounds__(512, 2) mk_fwd(Params P) {
    extern __shared__ __attribute__((aligned(16))) unsigned char lds[];
    const int G = gridDim.x, ngw = G * 8;
    LAS unsigned char* lds3 = (LAS unsigned char*)lds;
    volatile LAS unsigned* bst = (volatile LAS unsigned*)(lds3 + 131072 + 64);
    if (threadIdx.x < 4) bst[threadIdx.x] = 0u;
    __syncthreads();
    XcdBarrier xbar; xbar.bar = (unsigned*)(GAS unsigned*)(P.ws + WS_BAR); xbar.x = 0; xbar.st = bst;
    if (!MK_MULTI) xbar = xcd_barrier_post((unsigned*)(GAS unsigned*)(P.ws + WS_BAR), bst);
    int ph = 0;
#define RUN() (ph >= P.ph_lo && ph < P.ph_hi)
#define SEAM() do { ++ph; if (!MK_MULTI && ph > P.ph_lo && ph < P.ph_hi) { if (ph == 1) cg::this_grid().sync(); else xcd_barrier(xbar); } } while (0)
#define SKRED ((LAS f32x4*)(lds3 + 131072 + 8192))
#define PH_BEGIN int c = blockIdx.x; KP Pk = (KP)__builtin_amdgcn_kernarg_segment_ptr(); int tid = threadIdx.x; asm volatile("" : "+s"(c), "+s"(Pk), "+v"(tid)); unsigned char* ws = PWS; \
    const int lane = tid & 63, wid = __builtin_amdgcn_readfirstlane(tid >> 6); const int gw = c * 8 + wid; (void)lane; \
    float* hmain = POUT; float* hmeta = (float*)(ws + WS_HMETA); bf16_t* XN = (bf16_t*)(ws + WS_XN); bf16_t* HID = (bf16_t*)(ws + WS_R); \
    bf16_t *Ub = (bf16_t*)(ws + WS_U), *Qb = (bf16_t*)(ws + WS_Q), *Kb = (bf16_t*)(ws + WS_K), *VTb = (bf16_t*)(ws + WS_VT), *GATES = (bf16_t*)(ws + WS_GATES); \
    bf16_t* YSSM = (bf16_t*)(ws + WS_YSSM); bf16_t* YA = Ub; bf16_t* YB = (bf16_t*)(ws + WS_YB); bf16_t* MERGED = Kb; bf16_t* wb = (bf16_t*)(ws + WS_W) + (size_t)l * W_LAYER; \
    (void)hmain; (void)hmeta; (void)HID; (void)GATES; (void)YSSM; (void)YA; (void)YB; (void)MERGED; (void)wb; (void)VTb; (void)gw; (void)XN; (void)Ub; (void)Qb; (void)Kb;
    { const int l = 0; if (RUN()) { PH_BEGIN convert_weights(Pk, lds3, gw, ngw, wid, lane); norm_rows<1>(Pk, nullptr, gw, ngw, lane); } }
    SEAM();
    for (int l = 0; l < 2; ++l) {
        if (RUN()) { PH_BEGIN skinny_pair<0>(XN, wb + WO_W1, 2 * DFF, D, HID, DFF, (const float*)(ws + WS_SSQM), SKRED, c, G, wid, lane); pg8::Gemm g{XN, wb + WO_W1, nullptr, nullptr, D}; pg8::Sched2 S; S.init(TREAL, 2 * DFF, 0, 0, G, c); EpiPair<0> E{HID, DFF, (const float*)(ws + WS_SSQ)}; pg8::gemm_phase(lds3, g, S, E); }
        SEAM();
        if (RUN()) { PH_BEGIN skinny_resid(HID, wb + WO_W2, DFF, 0.5f, hmeta, XN, (float*)(ws + WS_SSQM), SKRED, c, G, wid, lane); pg8::Gemm g{HID, wb + WO_W2, nullptr, nullptr, DFF}; pg8::Sched2 S; S.init(TREAL, D, 0, 0, G, c); if (l == 0) { EpiResid<true> E{PIN(0), 0.5f, XN, (float*)(ws + WS_SSQ), (LAS float*)(lds3 + 131072 + 2048)}; pg8::gemm_phase(lds3, g, S, E); } else { EpiResid<false> E{nullptr, 0.5f, XN, (float*)(ws + WS_SSQ), (LAS float*)(lds3 + 131072 + 2048)}; pg8::gemm_phase(lds3, g, S, E); } }
        SEAM();
        if (RUN()) { PH_BEGIN f_rows(XN, wb + WO_WIN + (size_t)3584 * D, (float*)(ws + WS_FLOG), PIN(9) + l * NH, (const float*)(ws + WS_SSQ), gw, ngw, lane); skinny_in(XN, wb + WO_WIN, wb + WO_WV, Ub, Qb, Kb, VTb, GATES, (float*)(ws + WS_FLOG), PIN(8) + l * 2 * D, PIN(9) + l * NH, (const float*)(ws + WS_SSQM), SKRED, c, G, wid, lane); pg8::Gemm g{XN, wb + WO_WIN, wb + WO_WV, XN, D}; pg8::Sched2 S; S.init(TREAL, 3584, 512, TREAL, G, c);
            EpiIn E{Ub, Qb, Kb, VTb, GATES, (float*)(ws + WS_FLOG), PIN(8) + l * 2 * D, PIN(9) + l * NH, (const float*)(ws + WS_SSQ)}; pg8::gemm_phase(lds3, g, S, E); }
        SEAM();
        if (RUN()) { PH_BEGIN for (int rep = 0; rep < REP_SSM; ++rep) { cumscan(Pk, gw, ngw, lane); attn_norms(Pk, gw, ngw, lane); ssm_pass<0>(Pk, l, lds3, gw, ngw, wid, lane); } }
        SEAM();
        if (RUN()) { PH_BEGIN attn_phase(Pk, lds3, G, c, tid, wid, lane); ssm_pass<1>(Pk, l, lds3, gw, ngw, wid, lane); }
        SEAM();
        if (RUN()) { PH_BEGIN skinny_pair<1>(YSSM, wb + WO_GLU, 2 * SW, SW, YA, SW, nullptr, SKRED, c, G, wid, lane); pg8::Gemm g{YSSM, wb + WO_GLU, nullptr, nullptr, SW}; pg8::Sched2 S; S.init(TREAL, 2 * SW, 0, 0, G, c); EpiPair<1> E{YA, SW, nullptr}; pg8::gemm_phase(lds3, g, S, E); }
        SEAM();
        if (RUN()) { PH_BEGIN skinny_branch(YA, YB, wb + WO_BA, wb + WO_BB, GATES, MERGED, SKRED, c, G, wid, lane);
            pg8::Gemm g{YA, wb + WO_BA, YB, wb + WO_BB, SW}; pg8::Sched2 S; S.init(TREAL, D, 0, 0, G, c); S.pair = 1; EpiBranchBoth E{{GATES, MERGED}, {GATES, MERGED}}; pg8::gemm_phase(lds3, g, S, E); }
        SEAM();
        if (RUN()) { PH_BEGIN skinny_resid(MERGED, wb + WO_O, D, 1.0f, hmeta, XN, (float*)(ws + WS_SSQM), SKRED, c, G, wid, lane); pg8::Gemm g{MERGED, wb + WO_O, nullptr, nullptr, D}; pg8::Sched2 S; S.init(TREAL, D, 0, 0, G, c); EpiResid<false> E{nullptr, 1.0f, XN, (float*)(ws + WS_SSQ), (LAS float*)(lds3 + 131072 + 2048)}; pg8::gemm_phase(lds3, g, S, E); }
        SEAM();
        if (RUN()) { PH_BEGIN skinny_pair<0>(XN, wb + WO_W1B, 2 * DFF, D, HID, DFF, (const float*)(ws + WS_SSQM), SKRED, c, G, wid, lane); pg8::Gemm g{XN, wb + WO_W1B, nullptr, nullptr, D}; pg8::Sched2 S; S.init(TREAL, 2 * DFF, 0, 0, G, c); EpiPair<0> E{HID, DFF, (const float*)(ws + WS_SSQ)}; pg8::gemm_phase(lds3, g, S, E); }
        SEAM();
        if (RUN()) { PH_BEGIN skinny_resid(HID, wb + WO_W2B, DFF, 0.5f, hmeta, XN, (float*)(ws + WS_SSQM), SKRED, c, G, wid, lane); pg8::Gemm g{HID, wb + WO_W2B, nullptr, nullptr, DFF}; pg8::Sched2 S; S.init(TREAL, D, 0, 0, G, c); EpiResid<false> E{nullptr, 0.5f, XN, (float*)(ws + WS_SSQ), (LAS float*)(lds3 + 131072 + 2048)}; pg8::gemm_phase(lds3, g, S, E); }
        SEAM();
    }
    { const int l = 0; if (RUN()) { PH_BEGIN norm_rows<2>(Pk, PIN(26), gw, ngw, lane); } }
}

extern "C" void kernel_launch(void* const* d_in, const int* in_sizes, int n_in, void* d_out, int out_size, void* d_ws, size_t ws_size, hipStream_t stream) {
    static int ready = 0;
    if (!ready) {
        if (n_in != 27 || ws_size < WS_END) { fprintf(stderr, "kernel_launch: unexpected inputs (n_in %d, ws %zu < %zu)\n", n_in, ws_size, (size_t)WS_END); ready = -1; return; }
        if (hipFuncSetAttribute((const void*)mk_fwd, hipFuncAttributeMaxDynamicSharedMemorySize, LDS_BYTES) != hipSuccess) { fprintf(stderr, "kernel_launch: hipFuncSetAttribute failed\n"); ready = -1; return; }
        ready = 1;
    }
    if (ready < 0) return;
    Params p{};
    for (int i = 0; i < 27; ++i) p.in[i] = (const float*)d_in[i];
    p.out = (float*)d_out; p.ws = (unsigned char*)d_ws;
#if MK_MULTI
    for (int ph = 0; ph < NPH; ++ph) { p.ph_lo = ph; p.ph_hi = ph + 1; hipLaunchKernelGGL(mk_fwd, dim3(256), dim3(512), LDS_BYTES, stream, p); }
#else
    p.ph_lo = 0; p.ph_hi = NPH;
    (void)hipMemsetAsync((unsigned char*)d_ws + WS_BAR, 0, BAR_BYTES, stream);
    void* args[] = {&p};
    hipError_t e = hipLaunchCooperativeKernel((const void*)mk_fwd, dim3(256), dim3(512), args, LDS_BYTES, stream);
    if (e != hipSuccess) fprintf(stderr, "cooperative launch failed: %s\n", hipGetErrorString(e));
#endif
}
```

```cpp
#include <hip/hip_runtime.h>
#include <hip/hip_cooperative_groups.h>
#include <cstdio>
#include <cstdint>
namespace cg = cooperative_groups;

#ifndef MK_SKIP
#define MK_SKIP 0
#endif
#ifndef REP_ATTN
#define REP_ATTN 1
#endif
#ifndef REP_SSM
#define REP_SSM 1
#endif
#ifndef MK_MULTI
#define MK_MULTI 0
#endif

constexpr int D = 1024, NB = 16, SEQ = 2048, NMETA = 16, LPOS = SEQ + NMETA, T = NB * LPOS, TREAL = NB * SEQ;
constexpr int DFF = 2816, SW = 512, AW = 512, NH = 8, HD = 64, INW = 4104, NG = 32, NP = 64, NC = 16;
constexpr int NSEG = 4;
constexpr float RMS_EPS = 1e-6f, LOG2E = 1.4426950408889634f;
static_assert(T == 129 * 256, "row tiling");

typedef unsigned short bf16_t;
typedef short bf16x8 __attribute__((ext_vector_type(8)));
typedef float f32x4 __attribute__((ext_vector_type(4)));
typedef unsigned u32x4 __attribute__((ext_vector_type(4)));
typedef unsigned u32x2 __attribute__((ext_vector_type(2)));
#define LAS __attribute__((address_space(3)))

constexpr size_t MiB = 1u << 20;
constexpr size_t WS_HMETA = 0;
constexpr size_t WS_SSQM = 512 * 1024;
constexpr size_t WS_KMAX = 576 * 1024;
constexpr size_t WS_QMAX = 640 * 1024;
constexpr size_t WS_FLOG = 2 * MiB;
constexpr size_t WS_CUM = 4 * MiB;
constexpr size_t WS_SSMS = 6 * MiB;
constexpr size_t WS_BAR = 9 * MiB + 512 * 1024;
constexpr size_t BAR_BYTES = 16384;
constexpr size_t WS_W = 10 * MiB;
constexpr size_t WO_W1 = 0, WO_W2 = WO_W1 + (size_t)5632 * 1024, WO_WIN = WO_W2 + (size_t)1024 * 2816, WO_WV = WO_WIN + (size_t)3840 * 1024,
                 WO_GLU = WO_WV + (size_t)512 * 1024, WO_BA = WO_GLU + (size_t)1024 * 512, WO_BB = WO_BA + (size_t)1024 * 512, WO_O = WO_BB + (size_t)1024 * 512,
                 WO_W1B = WO_O + (size_t)1024 * 1024, WO_W2B = WO_W1B + (size_t)5632 * 1024, W_LAYER = WO_W2B + (size_t)1024 * 2816;
constexpr size_t WS_XN = WS_W + ((2 * W_LAYER * 2 + MiB - 1) / MiB) * MiB;
constexpr size_t XN_BYTES = (((size_t)T * 1024 * 2 + MiB - 1) / MiB) * MiB;
constexpr size_t WS_R = WS_XN + XN_BYTES;
constexpr size_t SZ512 = (size_t)T * 512 * 2;
constexpr size_t WS_U = WS_R, WS_Q = WS_U + SZ512, WS_K = WS_Q + SZ512, WS_VT = WS_K + SZ512, WS_GATES = WS_VT + SZ512, WS_YB = WS_GATES + (size_t)T * 2048 * 2, WS_SSQ = WS_YB + SZ512, WS_YSSM = WS_SSQ + (size_t)T * 4 * 4, WS_END = WS_YSSM + SZ512;
static_assert(WS_R + (size_t)T * 2816 * 2 <= WS_END, "ffn hidden fits in the overlay");

struct Params { const float* in[27]; float* out; unsigned char* ws; int ph_lo, ph_hi; };
#define GAS __attribute__((address_space(1)))
typedef const __attribute__((address_space(4))) struct Params* KP;
#define PIN(i) ((const float*)(const GAS float*)(Pk->in[i]))
#define PWS ((unsigned char*)(GAS unsigned char*)(Pk->ws))
#define POUT ((float*)(GAS float*)(Pk->out))

__device__ __forceinline__ unsigned f2bf(float f) { unsigned u = __builtin_bit_cast(unsigned, f); return (u + 0x7fffu + ((u >> 16) & 1u)) >> 16; }
__device__ __forceinline__ unsigned pk2(float lo, float hi) { return f2bf(lo) | (f2bf(hi) << 16); }
__device__ __forceinline__ float bf_lo(unsigned w) { return __builtin_bit_cast(float, w << 16); }
__device__ __forceinline__ float bf_hi(unsigned w) { return __builtin_bit_cast(float, w & 0xffff0000u); }
__device__ __forceinline__ float fast_exp2(float x) { return __builtin_amdgcn_exp2f(x); }
__device__ __forceinline__ float fast_rcp(float x) { return __builtin_amdgcn_rcpf(x); }
__device__ __forceinline__ float sigmoidf_(float x) { return fast_rcp(1.0f + fast_exp2(-x * LOG2E)); }
__device__ __forceinline__ float wave_sum(float v) {
#pragma unroll
    for (int o = 1; o < 64; o <<= 1) v += __shfl_xor(v, o);
    return v;
}
__device__ __forceinline__ int row_of(int b, int p) { return p < NMETA ? TREAL + p : b * SEQ + p - NMETA; }

namespace pg8 {
constexpr int BM = 256, BK = 64, HALF = 128, HTB = HALF * BK * 2, STAGE_BYTES = 8 * HTB, NXCD = 8, WGM = 8;
__host__ __device__ __forceinline__ int lds_byte(int r, int c) { const int st = (r >> 4) * 2 + (c >> 5), rr = r & 15, cc = c & 31, ob = rr * 64 + cc * 2; return st * 1024 + (ob ^ (((ob >> 9) & 1) << 5)); }
__host__ __device__ __forceinline__ void stage_rc(int b, int& R, int& C) { const int st = b / 1024, sb = b % 1024, swz = sb ^ (((sb >> 9) & 1) << 5); R = (st >> 1) * 16 + swz / 64; C = (st & 1) * 32 + (swz % 64) / 2; }
__host__ __device__ __forceinline__ int perm32(int rho) { const int n = rho >> 4, i = rho & 15; return 8 * (i >> 2) + 4 * n + (i & 3); }

struct Unit { int pm, pn, sub; };
struct Gemm { const bf16_t* A0; const bf16_t* B0; const bf16_t* A1; const bf16_t* B1; int K; };

struct Sched2 {
    int nM0, nN0, nwg0, nM1, nN1, nwg1, G, c;
    __device__ void init(int M0, int N0, int M1, int N1, int G_, int c_) { nM0 = M0 / BM; nN0 = N0 / BM; nwg0 = nM0 * nN0; nM1 = M1 / BM; nN1 = N1 / BM; nwg1 = nM1 * nN1; G = G_; c = c_; }
    __device__ static void map(int wgid, int nwg, int nM, int nN, Unit& u) {
        { const int q = nwg / NXCD, r = nwg % NXCD, xcd = wgid % NXCD, off = wgid / NXCD; wgid = (xcd < r ? xcd * (q + 1) : r * (q + 1) + (xcd - r) * q) + off; }
        const int nig = WGM * nN, gid = wgid / nig, fm = gid * WGM, gsz = (nM - fm) < WGM ? (nM - fm) : WGM;
        u.pm = fm + ((wgid % nig) % gsz); u.pn = (wgid % nig) / gsz;
    }
    __device__ bool next(int i, Unit& u) const {
        long L = (long)i * G + c; if (L >= nwg0 + nwg1) return false;
        if (L < nwg0) { u.sub = 0; map((int)L, nwg0, nM0, nN0, u); } else { u.sub = 1; map((int)L - nwg0, nwg1, nM1, nN1, u); }
        return true;
    }
};

typedef float f32x2_t __attribute__((ext_vector_type(2))); typedef __bf16 bf16x2_t __attribute__((ext_vector_type(2)));
__device__ __forceinline__ unsigned cvt_pk_bf16(float lo, float hi) { f32x2_t v = {lo, hi}; bf16x2_t b = __builtin_convertvector(v, bf16x2_t); return __builtin_bit_cast(unsigned, b); }

template <class Epi>
__device__ __forceinline__ void gemm_phase(LAS unsigned char* lds, const Gemm g, const Sched2& S, const Epi& E) {
    int tid_ = threadIdx.x; asm volatile("" : "+v"(tid_));
    const int tid = tid_, wid = __builtin_amdgcn_readfirstlane(tid >> 6), lane = tid & 63, wr = wid >> 2, wc = wid & 3, fr = lane & 15, fq = lane >> 4;
    const int K = g.K, nt = K / BK;
    unsigned voffA[2], voffB[2];
#pragma unroll
    for (int i = 0; i < 2; ++i) { int R, C; stage_rc(tid * 16 + i * 8192, R, C); const int Rb = Epi::PERM ? ((R & ~31) + perm32(R & 31)) : R;
        voffA[i] = (unsigned)(R * K + C) * 2u; voffB[i] = (unsigned)(Rb * K + C) * 2u; }
    const size_t kstep = (size_t)(BK * 2);
    const size_t hstep = (size_t)HALF * K * 2;
    const size_t tstep = 2 * hstep;
    const unsigned ldsw = (unsigned)wid * 1024u;
    const int aoff = lds_byte(wr * 64 + fr, fq * 8), boff = lds_byte(wc * 32 + fr, fq * 8);
#define PG8_SA(b, h) (((b) * 2 + (h)) * HTB)
#define PG8_SB(b, h) ((4 + (b) * 2 + (h)) * HTB)
#define PG8_STAGE(bufoff, gbase, voff) do { _Pragma("unroll") for (int _i = 0; _i < 2; ++_i) \
        __builtin_amdgcn_global_load_lds((const unsigned*)((const char*)(gbase) + (voff)[_i]), (LAS unsigned*)(lds + (bufoff) + ldsw + _i * 8192), 16, 0, 0); } while (0)
#define PG8_LDA(dst, b, h) do { _Pragma("unroll") for (int m = 0; m < 4; ++m) _Pragma("unroll") for (int k = 0; k < 2; ++k) dst[m][k] = *(const LAS bf16x8*)(lds + PG8_SA(b, h) + aoff + m * 2048 + k * 1024); } while (0)
#define PG8_LDB(dst, b, h) do { _Pragma("unroll") for (int n = 0; n < 2; ++n) _Pragma("unroll") for (int k = 0; k < 2; ++k) dst[n][k] = *(const LAS bf16x8*)(lds + PG8_SB(b, h) + boff + n * 2048 + k * 1024); } while (0)
#define PG8_MMA(ai, bj, At, Bt) do { __builtin_amdgcn_s_setprio(1); _Pragma("unroll") for (int m = 0; m < 4; ++m) _Pragma("unroll") for (int n = 0; n < 2; ++n) _Pragma("unroll") for (int k = 0; k < 2; ++k) \
        acc[ai][bj][m][n] = __builtin_amdgcn_mfma_f32_16x16x32_bf16(Bt[n][k], At[m][k], acc[ai][bj][m][n], 0, 0, 0); __builtin_amdgcn_s_setprio(0); } while (0)
#define PG8_WAIT_V(n) asm volatile("s_waitcnt vmcnt(" #n ")" ::: "memory")
#define PG8_WAIT_L(n) asm volatile("s_waitcnt lgkmcnt(" #n ")" ::: "memory")
#define PG8_BAR __builtin_amdgcn_s_barrier()
#define PG8_SCHED __builtin_amdgcn_sched_barrier(0)
    Unit cur, nxt; int ui = 0;
    if (!S.next(0, cur)) return;
    f32x4 acc[2][2][4][2];
#pragma unroll
    for (int a = 0; a < 2; ++a)
#pragma unroll
        for (int b = 0; b < 2; ++b)
#pragma unroll
            for (int m = 0; m < 4; ++m)
#pragma unroll
                for (int n = 0; n < 2; ++n) acc[a][b][m][n] = (f32x4){0.f, 0.f, 0.f, 0.f};
    bf16x8 At[4][2], B0[2][2], B1[2][2];
    const char* cA = (const char*)(cur.sub ? g.A1 : g.A0) + (size_t)cur.pm * tstep; const char* cB = (const char*)(cur.sub ? g.B1 : g.B0) + (size_t)cur.pn * tstep;
    {
        PG8_STAGE(PG8_SB(0, 0), cB, voffB); PG8_STAGE(PG8_SB(0, 1), cB + hstep, voffB); PG8_STAGE(PG8_SA(0, 0), cA, voffA); PG8_STAGE(PG8_SA(0, 1), cA + hstep, voffA);
        if (wr == 1) PG8_BAR;
        PG8_WAIT_V(2); PG8_BAR;
        PG8_STAGE(PG8_SB(1, 0), cB + kstep, voffB); PG8_STAGE(PG8_SA(1, 0), cA + kstep, voffA); PG8_STAGE(PG8_SB(1, 1), cB + hstep + kstep, voffB);
        PG8_WAIT_V(6); PG8_BAR;
    }
    for (;;) {
        const bool has_next = S.next(ui + 1, nxt);
        const char* nA = has_next ? (const char*)(nxt.sub ? g.A1 : g.A0) + (size_t)nxt.pm * tstep : cA; const char* nB = has_next ? (const char*)(nxt.sub ? g.B1 : g.B0) + (size_t)nxt.pn * tstep : cB;
        for (int t = 0; t < nt; t += 2) {
            const bool last = (t == nt - 2);
            const char* a1 = cA + (size_t)(t + 1) * kstep;
            const char* a2 = last ? nA : cA + (size_t)(t + 2) * kstep; const char* b2 = last ? nB : cB + (size_t)(t + 2) * kstep;
            const char* a3 = a2 + kstep; const char* b3 = b2 + kstep;
            PG8_LDB(B0, 0, 0); PG8_LDB(B1, 0, 1); PG8_SCHED; PG8_LDA(At, 0, 0); PG8_STAGE(PG8_SA(1, 1), a1 + hstep, voffA);
            PG8_WAIT_V(8); PG8_WAIT_L(0); PG8_BAR; PG8_MMA(0, 0, At, B0); PG8_MMA(0, 1, At, B1); PG8_BAR; PG8_SCHED;
            PG8_LDA(At, 0, 1); PG8_STAGE(PG8_SB(0, 0), b2, voffB); PG8_STAGE(PG8_SB(0, 1), b2 + hstep, voffB); PG8_STAGE(PG8_SA(0, 0), a2, voffA);
            PG8_WAIT_V(8); PG8_WAIT_L(0); PG8_BAR; PG8_MMA(1, 0, At, B0); PG8_MMA(1, 1, At, B1); PG8_BAR; PG8_SCHED;
            PG8_LDB(B0, 1, 0); PG8_LDB(B1, 1, 1); PG8_SCHED; PG8_LDA(At, 1, 0); PG8_STAGE(PG8_SA(0, 1), a2 + hstep, voffA);
            PG8_WAIT_V(8); PG8_WAIT_L(0); PG8_BAR; PG8_MMA(0, 0, At, B0); PG8_MMA(0, 1, At, B1); PG8_BAR; PG8_SCHED;
            PG8_LDA(At, 1, 1); PG8_STAGE(PG8_SB(1, 0), b3, voffB); PG8_STAGE(PG8_SB(1, 1), b3 + hstep, voffB); PG8_STAGE(PG8_SA(1, 0), a3, voffA);
            PG8_WAIT_V(8); PG8_WAIT_L(0); PG8_BAR; PG8_MMA(1, 0, At, B0); PG8_MMA(1, 1, At, B1); PG8_BAR; PG8_SCHED;
        }
        if (wr == 0) PG8_BAR;
        E(acc, cur, wr, wc, fr, fq);
        if (!has_next) break;
#pragma unroll
        for (int a = 0; a < 2; ++a)
#pragma unroll
            for (int b = 0; b < 2; ++b)
#pragma unroll
                for (int m = 0; m < 4; ++m)
#pragma unroll
                    for (int n = 0; n < 2; ++n) acc[a][b][m][n] = (f32x4){0.f, 0.f, 0.f, 0.f};
        cur = nxt; cA = nA; cB = nB; ++ui;
        if (wr == 1) PG8_BAR;
    }
    PG8_WAIT_V(0);
    PG8_BAR;
#undef PG8_SA
#undef PG8_SB
#undef PG8_STAGE
#undef PG8_LDA
#undef PG8_LDB
#undef PG8_MMA
#undef PG8_WAIT_V
#undef PG8_WAIT_L
#undef PG8_BAR
#undef PG8_SCHED
}
}

typedef f32x4 Acc[2][2][4][2];
__device__ __forceinline__ float row_rs(const float* SSQ, size_t row) {
    const f32x4 a = *(const f32x4*)(SSQ + row * 4);
    return __builtin_amdgcn_rsqf(((a.x + a.y) + (a.z + a.w)) * (1.0f / D) + RMS_EPS);
}
template <int MODE> struct EpiPair {
    static constexpr bool PERM = true;
    bf16_t* O; int ldo; const float* SSQ;
    __device__ __forceinline__ void operator()(const Acc& acc, const pg8::Unit& u, int wr, int wc, int fr, int fq) const {
        const int row0 = u.pm * 256 + wr * 64 + fr, colp = u.pn * 256 + wc * 32 + 8 * fq;
#pragma unroll
        for (int ai = 0; ai < 2; ++ai)
#pragma unroll
            for (int m = 0; m < 4; ++m) { bf16_t* rowp = O + (size_t)(row0 + ai * 128 + m * 16) * ldo;
                const float rs = MODE == 0 ? row_rs(SSQ, (size_t)(row0 + ai * 128 + m * 16)) : 1.0f;
#pragma unroll
                for (int bj = 0; bj < 2; ++bj) { const f32x4 a = acc[ai][bj][m][0] * rs, b = acc[ai][bj][m][1] * rs; float v[4];
#pragma unroll
                    for (int i = 0; i < 4; ++i) v[i] = MODE == 0 ? a[i] * sigmoidf_(a[i]) * b[i] : a[i] * sigmoidf_(b[i]);
                    u32x2 w; w.x = pg8::cvt_pk_bf16(v[0], v[1]); w.y = pg8::cvt_pk_bf16(v[2], v[3]);
                    *(u32x2*)(rowp + ((colp + bj * 128) >> 1)) = w; } }
    }
};
template <bool SRC32> struct EpiResid {
    static constexpr bool PERM = false;
    const float* hsrc; float scale; bf16_t* HB; float* SSQ; LAS float* part;
    __device__ __forceinline__ void operator()(const Acc& acc, const pg8::Unit& u, int wr, int wc, int fr, int fq) const {
        const float* sbase = hsrc + (size_t)u.pm * 256 * D;
        bf16_t* hbase = HB + (size_t)u.pm * 256 * D;
        const int rl0 = wr * 64 + fr, col0 = u.pn * 256 + wc * 32 + 4 * fq;
        unsigned off = (unsigned)(rl0 * D + col0);
        f32x4 cur[4], nxt[4]; u32x2 curb[4], nxtb[4];
#pragma unroll
        for (int q = 0; q < 4; ++q) { if (SRC32) cur[q] = *(const f32x4*)(sbase + off + (q >> 1) * 128 + (q & 1) * 16); else curb[q] = *(const u32x2*)(hbase + off + (q >> 1) * 128 + (q & 1) * 16); }
#pragma unroll
        for (int ai = 0; ai < 2; ++ai)
#pragma unroll
            for (int m = 0; m < 4; ++m) { const int rl = rl0 + ai * 128 + m * 16; float ss = 0.f;
                const unsigned offn = off + (unsigned)((m == 3 ? (128 - 48) : 16) * D);
                if (!(ai == 1 && m == 3)) {
#pragma unroll
                    for (int q = 0; q < 4; ++q) { if (SRC32) nxt[q] = *(const f32x4*)(sbase + offn + (q >> 1) * 128 + (q & 1) * 16); else nxtb[q] = *(const u32x2*)(hbase + offn + (q >> 1) * 128 + (q & 1) * 16); }
                }
#pragma unroll
                for (int bj = 0; bj < 2; ++bj)
#pragma unroll
                    for (int n = 0; n < 2; ++n) { const int q = bj * 2 + n;
                        const f32x4 old = SRC32 ? cur[q] : (f32x4){bf_lo(curb[q].x), bf_hi(curb[q].x), bf_lo(curb[q].y), bf_hi(curb[q].y)};
                        const f32x4 v = old + acc[ai][bj][m][n] * scale;
                        ss += (v.x * v.x + v.y * v.y) + (v.z * v.z + v.w * v.w);
                        u32x2 w; w.x = pg8::cvt_pk_bf16(v.x, v.y); w.y = pg8::cvt_pk_bf16(v.z, v.w); *(u32x2*)(hbase + off + bj * 128 + n * 16) = w; }
                ss += __shfl_xor(ss, 16); ss += __shfl_xor(ss, 32);
                if (fq == 0) part[rl * 4 + wc] = ss;
#pragma unroll
                for (int q = 0; q < 4; ++q) { cur[q] = nxt[q]; curb[q] = nxtb[q]; }
                off = offn;
                asm volatile("" : "+v"(off) :: "memory"); }
        asm volatile("s_waitcnt lgkmcnt(0)" ::: "memory"); __builtin_amdgcn_s_barrier(); asm volatile("" ::: "memory");
        const int tid = (wr * 4 + wc) * 64 + fq * 16 + fr;
        if (tid < 256) { const f32x4 q = *(const LAS f32x4*)(part + tid * 4); SSQ[((size_t)u.pm * 256 + tid) * 4 + u.pn] = (q.x + q.y) + (q.z + q.w); }
    }
};
struct EpiIn {
    static constexpr bool PERM = true;
    bf16_t *U, *Q, *Kb, *VT, *GATES; float* FLOG; const float* b_gate; const float* b_f; const float* SSQ;
    __device__ __forceinline__ void operator()(const Acc& acc, const pg8::Unit& u, int wr, int wc, int fr, int fq) const {
        const int row0 = u.pm * 256 + wr * 64 + fr, colt = wc * 32 + 8 * fq;
        if (u.sub == 1) {
            f32x4 rt[2][2];
#pragma unroll
            for (int bj = 0; bj < 2; ++bj)
#pragma unroll
                for (int n = 0; n < 2; ++n)
#pragma unroll
                    for (int i = 0; i < 4; ++i) rt[bj][n][i] = row_rs(SSQ, (size_t)(u.pn * 256 + colt + bj * 128 + 4 * n + i));
#pragma unroll
            for (int ai = 0; ai < 2; ++ai)
#pragma unroll
                for (int m = 0; m < 4; ++m) { bf16_t* rowp = VT + (size_t)(row0 + ai * 128 + m * 16) * T + u.pn * 256 + colt;
#pragma unroll
                    for (int bj = 0; bj < 2; ++bj) { const f32x4 v0 = acc[ai][bj][m][0] * rt[bj][0], v1 = acc[ai][bj][m][1] * rt[bj][1]; u32x4 w;
                        w.x = pg8::cvt_pk_bf16(v0[0], v0[1]); w.y = pg8::cvt_pk_bf16(v0[2], v0[3]); w.z = pg8::cvt_pk_bf16(v1[0], v1[1]); w.w = pg8::cvt_pk_bf16(v1[2], v1[3]);
                        *(u32x4*)(rowp + bj * 128) = w; } }
            return;
        }
        const int pn = u.pn;
        if (pn < 6) {
            bf16_t* base = pn < 2 ? U + pn * 256 : (pn < 4 ? Q + (pn - 2) * 256 : Kb + (pn - 4) * 256);
            const float sc = (pn == 2 || pn == 3) ? 0.125f * LOG2E : 1.0f;
#pragma unroll
            for (int ai = 0; ai < 2; ++ai)
#pragma unroll
                for (int m = 0; m < 4; ++m) { bf16_t* rowp = base + (size_t)(row0 + ai * 128 + m * 16) * 512 + colt;
                    const float rsc = sc * row_rs(SSQ, (size_t)(row0 + ai * 128 + m * 16));
#pragma unroll
                    for (int bj = 0; bj < 2; ++bj) { const f32x4 v0 = acc[ai][bj][m][0] * rsc, v1 = acc[ai][bj][m][1] * rsc; u32x4 w;
                        w.x = pg8::cvt_pk_bf16(v0[0], v0[1]); w.y = pg8::cvt_pk_bf16(v0[2], v0[3]); w.z = pg8::cvt_pk_bf16(v1[0], v1[1]); w.w = pg8::cvt_pk_bf16(v1[2], v1[3]);
                        *(u32x4*)(rowp + bj * 128) = w; } }
        } else if (pn < 14) {
            const int gc = (pn - 6) * 256 + colt;
            f32x4 bv[2][2];
#pragma unroll
            for (int bj = 0; bj < 2; ++bj)
#pragma unroll
                for (int n = 0; n < 2; ++n) bv[bj][n] = *(const f32x4*)(b_gate + gc + bj * 128 + 4 * n);
#pragma unroll
            for (int ai = 0; ai < 2; ++ai)
#pragma unroll
                for (int m = 0; m < 4; ++m) { bf16_t* rowp = GATES + (size_t)(row0 + ai * 128 + m * 16) * 2048 + gc;
                    const float rs = row_rs(SSQ, (size_t)(row0 + ai * 128 + m * 16));
#pragma unroll
                    for (int bj = 0; bj < 2; ++bj) { f32x4 v0 = acc[ai][bj][m][0] * rs + bv[bj][0], v1 = acc[ai][bj][m][1] * rs + bv[bj][1];
#pragma unroll
                        for (int i = 0; i < 4; ++i) { v0[i] = sigmoidf_(v0[i]); v1[i] = sigmoidf_(v1[i]); }
                        u32x4 w; w.x = pg8::cvt_pk_bf16(v0[0], v0[1]); w.y = pg8::cvt_pk_bf16(v0[2], v0[3]); w.z = pg8::cvt_pk_bf16(v1[0], v1[1]); w.w = pg8::cvt_pk_bf16(v1[2], v1[3]);
                        *(u32x4*)(rowp + bj * 128) = w; } }
        } else {
            if (wc == 0 && fq == 0) {
                const f32x4 b0 = *(const f32x4*)(b_f), b1 = *(const f32x4*)(b_f + 4);
#pragma unroll
                for (int ai = 0; ai < 2; ++ai)
#pragma unroll
                    for (int m = 0; m < 4; ++m) { float* rowp = FLOG + (size_t)(row0 + ai * 128 + m * 16) * 8;
                        const float rs = row_rs(SSQ, (size_t)(row0 + ai * 128 + m * 16));
                        f32x4 z0 = acc[ai][0][m][0] * rs + b0, z1 = acc[ai][0][m][1] * rs + b1;
#pragma unroll
                        for (int i = 0; i < 4; ++i) {
                            z0[i] = (fminf(z0[i], 0.f) - __logf(1.0f + __expf(-fabsf(z0[i])))) * LOG2E;
                            z1[i] = (fminf(z1[i], 0.f) - __logf(1.0f + __expf(-fabsf(z1[i])))) * LOG2E; }
                        *(f32x4*)(rowp) = z0; *(f32x4*)(rowp + 4) = z1; }
            }
        }
    }
};
template <int SECOND> struct EpiBranch {
    static constexpr bool PERM = true;
    const bf16_t* GATES; bf16_t* MERGED;
    __device__ __forceinline__ void operator()(const Acc& acc, const pg8::Unit& u, int wr, int wc, int fr, int fq) const {
        const int row0 = u.pm * 256 + wr * 64 + fr, col0 = u.pn * 256 + wc * 32 + 8 * fq;
#pragma unroll
        for (int ai = 0; ai < 2; ++ai)
#pragma unroll
            for (int m = 0; m < 4; ++m) { const size_t r = (size_t)(row0 + ai * 128 + m * 16);
#pragma unroll
                for (int bj = 0; bj < 2; ++bj) { const int c = col0 + bj * 128;
                    const u32x4 gw = *(const u32x4*)(GATES + r * 2048 + SECOND * 1024 + c);
                    const f32x4 a0 = acc[ai][bj][m][0], a1 = acc[ai][bj][m][1];
                    float v[8] = {bf_lo(gw.x) * a0[0], bf_hi(gw.x) * a0[1], bf_lo(gw.y) * a0[2], bf_hi(gw.y) * a0[3], bf_lo(gw.z) * a1[0], bf_hi(gw.z) * a1[1], bf_lo(gw.w) * a1[2], bf_hi(gw.w) * a1[3]};
                    if (SECOND) { const u32x4 pw = *(const u32x4*)(MERGED + r * 1024 + c);
                        v[0] += bf_lo(pw.x); v[1] += bf_hi(pw.x); v[2] += bf_lo(pw.y); v[3] += bf_hi(pw.y); v[4] += bf_lo(pw.z); v[5] += bf_hi(pw.z); v[6] += bf_lo(pw.w); v[7] += bf_hi(pw.w); }
                    u32x4 w; w.x = pg8::cvt_pk_bf16(v[0], v[1]); w.y = pg8::cvt_pk_bf16(v[2], v[3]); w.z = pg8::cvt_pk_bf16(v[4], v[5]); w.w = pg8::cvt_pk_bf16(v[6], v[7]);
                    *(u32x4*)(MERGED + r * 1024 + c) = w; } }
    }
};

__device__ __forceinline__ void wt_item(const float* W, const float* W2, const float* gsc, int ldn, int K, int Nout, int mode, bf16_t* dst, LAS float* scr, int item, int lane) {
    const int nblk = Nout / 32, kb = item / nblk, nb = item % nblk, k0 = 64 * kb, n0 = 32 * nb;
    const int n = n0 + (lane & 31); bool zero = false; const float* src;
    { const int grp = n >> 3, w = n & 7, j = grp * 4 + (w & 3);
      if (mode == 0) src = W + n;
      else if (mode == 1) src = ((w >> 2) ? W2 : W) + j;
      else if (mode == 2) src = W + (w >> 2) * 512 + j;
      else if (mode == 3) { int col = n; if (n >= 1536) col = 2056 + (n - 1536); if (n >= 3584) col = 2048 + (n - 3584); if (n >= 3592) { col = 0; zero = true; } src = W + col; }
      else src = W + 1536 + n; }
#pragma unroll
    for (int i = 0; i < 32; ++i) { const int kk = 2 * i + (lane >> 5); scr[kk * 33 + (lane & 31)] = zero ? 0.f : src[(size_t)(k0 + kk) * ldn] * (gsc ? gsc[k0 + kk] : 1.0f); }
    __builtin_amdgcn_fence(__ATOMIC_RELEASE, "wavefront"); asm volatile("s_waitcnt lgkmcnt(0)" ::: "memory");
    const int c = lane & 7;
#pragma unroll
    for (int j = 0; j < 4; ++j) { const int nn = (lane >> 3) + 8 * j; const LAS float* s = scr + (8 * c) * 33 + nn;
        u32x4 o; o.x = pk2(s[0 * 33], s[1 * 33]); o.y = pk2(s[2 * 33], s[3 * 33]); o.z = pk2(s[4 * 33], s[5 * 33]); o.w = pk2(s[6 * 33], s[7 * 33]);
        *(u32x4*)(dst + (size_t)(n0 + nn) * K + k0 + 8 * c) = o; }
    asm volatile("s_waitcnt lgkmcnt(0)" ::: "memory");
}
__device__ __forceinline__ void convert_weights(KP Pk, LAS unsigned char* lds, int gw, int ngw, int wid, int lane) {
    LAS float* scr = (LAS float*)(lds + wid * 16384);
    for (int lm = 0; lm < 20; ++lm) {
        const int l = lm / 10, m = lm % 10;
        bf16_t* wb = (bf16_t*)(PWS + WS_W) + (size_t)l * W_LAYER;
        const float* W = nullptr; const float* W2 = nullptr; const float* gsc = nullptr; int ldn = D, K = D, Nout = D, mode = 0; size_t doff = 0;
        if (m == 0)      { W = PIN(3) + (size_t)l * D * DFF; W2 = PIN(4) + (size_t)l * D * DFF; ldn = DFF; K = D; Nout = 2 * DFF; mode = 1; doff = WO_W1; gsc = PIN(2) + l * D; }
        else if (m == 1) { W = PIN(5) + (size_t)l * DFF * D; ldn = D; K = DFF; Nout = D; mode = 0; doff = WO_W2; }
        else if (m == 2) { W = PIN(7) + (size_t)l * D * INW; ldn = INW; K = D; Nout = 3840; mode = 3; doff = WO_WIN; gsc = PIN(6) + l * D; }
        else if (m == 3) { W = PIN(7) + (size_t)l * D * INW; ldn = INW; K = D; Nout = 512; mode = 4; doff = WO_WV; gsc = PIN(6) + l * D; }
        else if (m == 4) { W = PIN(18) + (size_t)l * SW * 2 * SW; ldn = 2 * SW; K = SW; Nout = 2 * SW; mode = 2; doff = WO_GLU; }
        else if (m == 5) { W = PIN(19) + (size_t)l * SW * D; ldn = D; K = SW; Nout = D; mode = 0; doff = WO_BA; }
        else if (m == 6) { W = PIN(20) + (size_t)l * AW * D; ldn = D; K = AW; Nout = D; mode = 0; doff = WO_BB; }
        else if (m == 7) { W = PIN(21) + (size_t)l * D * D; ldn = D; K = D; Nout = D; mode = 0; doff = WO_O; }
        else if (m == 8) { W = PIN(23) + (size_t)l * D * DFF; W2 = PIN(24) + (size_t)l * D * DFF; ldn = DFF; K = D; Nout = 2 * DFF; mode = 1; doff = WO_W1B; gsc = PIN(22) + l * D; }
        else             { W = PIN(25) + (size_t)l * DFF * D; ldn = D; K = DFF; Nout = D; mode = 0; doff = WO_W2B; }
        const int items = (K / 64) * (Nout / 32);
        for (int it = gw; it < items; it += ngw) wt_item(W, W2, gsc, ldn, K, Nout, mode, wb + doff, scr, it, lane);
    }
}
template <int MODE>
__device__ __forceinline__ void norm_rows(KP Pk, const float* g, int gw, int ngw, int lane) {
    float* hmain = POUT; float* hmeta = (float*)(PWS + WS_HMETA); bf16_t* XN = (bf16_t*)(PWS + WS_XN); float* SSQ = (float*)(PWS + WS_SSQ);
    f32x4 gv[4];
#pragma unroll
    for (int j = 0; j < 4; ++j) gv[j] = MODE == 2 ? *((const f32x4*)g + lane + 64 * j) : (f32x4){1.f, 1.f, 1.f, 1.f};
    const int nrows = MODE == 2 ? TREAL : TREAL + NMETA;
#pragma unroll 2
    for (int r = gw; r < nrows; r += ngw) {
        float* hrow = r < TREAL ? hmain + (size_t)r * D : hmeta + (size_t)(r - TREAL) * D;
        const float* src = hrow;
        if (MODE == 1) src = r < TREAL ? PIN(0) + (size_t)r * D : PIN(1) + (size_t)((r - TREAL) & 15) * D;
        f32x4 v[4]; float s = 0.f;
#pragma unroll
        for (int j = 0; j < 4; ++j) {
            if (MODE == 2) { const u32x2 w = *((const u32x2*)(XN + (size_t)r * D) + lane + 64 * j); v[j] = (f32x4){bf_lo(w.x), bf_hi(w.x), bf_lo(w.y), bf_hi(w.y)}; }
            else v[j] = *((const f32x4*)src + lane + 64 * j);
            s += (v[j].x * v[j].x + v[j].y * v[j].y) + (v[j].z * v[j].z + v[j].w * v[j].w); }
        const float tot = wave_sum(s);
        if (MODE == 1) {
            unsigned long long* o8 = (unsigned long long*)(XN + (size_t)r * D) + lane;
#pragma unroll
            for (int j = 0; j < 4; ++j) { if (r >= TREAL) *((f32x4*)hrow + lane + 64 * j) = v[j]; o8[64 * j] = (unsigned long long)pk2(v[j].x, v[j].y) | ((unsigned long long)pk2(v[j].z, v[j].w) << 32); }
            if (lane < 4) SSQ[(size_t)r * 4 + lane] = lane == 0 ? tot : 0.f;
            if (r >= TREAL) ((float*)(PWS + WS_SSQM))[(r - TREAL) * 64 + lane] = lane == 0 ? tot : 0.f;
        } else {
            const float rs = 1.0f / sqrtf(tot * (1.0f / D) + RMS_EPS);
#pragma unroll
            for (int j = 0; j < 4; ++j) *((f32x4*)hrow + lane + 64 * j) = v[j] * rs * gv[j];
        }
    }
}
__device__ __forceinline__ void cumscan(KP Pk, int gw, int ngw, int lane) {
    const float* FLOG = (const float*)(PWS + WS_FLOG); float* CUM = (float*)(PWS + WS_CUM);
    for (int unit = gw; unit < NB * NH; unit += ngw) {
        const int b = unit >> 3, h = unit & 7, p0 = lane * 33;
        float vv[33];
#pragma unroll
        for (int i = 0; i < 33; ++i) { const int p = p0 + i; vv[i] = p < LPOS ? FLOG[(size_t)row_of(b, p) * 8 + h] : 0.f; }
        float run = 0.f;
#pragma unroll
        for (int i = 0; i < 33; ++i) { run += vv[i]; vv[i] = run; }
        float inc = run;
#pragma unroll
        for (int o = 1; o < 64; o <<= 1) { const float t = __shfl_up(inc, o); if (lane >= o) inc += t; }
        const float excl = inc - run;
#pragma unroll
        for (int i = 0; i < 33; ++i) { const int p = p0 + i; if (p < LPOS) CUM[(size_t)unit * LPOS + p] = excl + vv[i]; }
    }
}
__device__ __forceinline__ int seg_blk0(int s) { return s == 0 ? 0 : 1 + 32 * s; }
typedef short s16x4 __attribute__((ext_vector_type(4)));
constexpr int SSM_LDS_WAVE = 14336;
template <int PASS>
__device__ __forceinline__ void ssm_pass(KP Pk, int l, LAS unsigned char* lds, int gw, int ngw, int wid, int lane) {
    const bf16_t* U = (const bf16_t*)(PWS + WS_U); bf16_t* Y = (bf16_t*)(PWS + WS_YSSM); float* SS = (float*)(PWS + WS_SSMS);
    LAS float* bub = (LAS float*)(lds + wid * SSM_LDS_WAVE);
    LAS unsigned* hbuf = (LAS unsigned*)(lds + wid * SSM_LDS_WAVE + 9216);
    const int tq = lane & 15, jq = lane >> 4;
    for (int task = gw; task < NB * NG * NSEG; task += ngw) {
        const int unit = task / NSEG, seg = task % NSEG, b = unit / NG, g = unit % NG, p = lane;
        const float dt = __expf(PIN(12)[l * NG + g]);
        const float lre = PIN(10)[(l * NG + g) * NP + p], lim = PIN(11)[(l * NG + g) * NP + p];
        const float mag = __expf(lre * dt), ang = lim * dt;
        const float abr = mag * cosf(ang), abi = mag * sinf(ang);
        const float den = lre * lre + lim * lim, nre = abr - 1.0f;
        const float cre = (nre * lre + abi * lim) / den, cim = (abi * lre - nre * lim) / den;
        s16x4 Af[8];
#pragma unroll
        for (int nb = 0; nb < 4; ++nb) { const int pp = 16 * nb + tq; const float crs = __shfl(cre, pp), cis = __shfl(cim, pp);
            const f32x4 br = *(const f32x4*)(PIN(13) + ((size_t)(l * NG + g) * NP + pp) * NC + 4 * jq), bi = *(const f32x4*)(PIN(14) + ((size_t)(l * NG + g) * NP + pp) * NC + 4 * jq);
            s16x4 fr_, fi_;
#pragma unroll
            for (int i = 0; i < 4; ++i) { fr_[i] = (short)f2bf(crs * br[i] - cis * bi[i]); fi_[i] = (short)f2bf(crs * bi[i] + cis * br[i]); }
            Af[nb * 2] = fr_; Af[nb * 2 + 1] = fi_; }
        float hr = 0.f, hi = 0.f;
        const int blk0 = seg_blk0(seg), blk1 = seg_blk0(seg + 1);
        bf16x8 Cf[4]; f32x4 dsk4 = {0.f, 0.f, 0.f, 0.f};
        if (PASS == 1) {
            float a16r = abr, a16i = abi;
#pragma unroll
            for (int i = 0; i < 4; ++i) { const float r2 = a16r * a16r - a16i * a16i, i2 = 2.f * a16r * a16i; a16r = r2; a16i = i2; }
            for (int s = 0; s < seg; ++s) {
                const int nb = seg_blk0(s + 1) - seg_blk0(s); float pr = 1.f, pi = 0.f;
                for (int i = 0; i < nb; ++i) { const float r2 = pr * a16r - pi * a16i, i2 = pr * a16i + pi * a16r; pr = r2; pi = i2; }
                const float sr = SS[((size_t)unit * NSEG + s) * 128 + p], si = SS[((size_t)unit * NSEG + s) * 128 + 64 + p];
                const float r2 = pr * hr - pi * hi + sr, i2 = pr * hi + pi * hr + si; hr = r2; hi = i2;
            }
#pragma unroll
            for (int kk = 0; kk < 4; ++kk) { bf16x8 f;
#pragma unroll
                for (int i = 0; i < 8; ++i) { const int k = kk * 32 + jq * 8 + i, st = k >> 1;
                    const float v = (k & 1) ? -PIN(16)[((size_t)(l * NG + g) * NC + tq) * NP + st] : PIN(15)[((size_t)(l * NG + g) * NC + tq) * NP + st];
                    f[i] = (short)f2bf(v); }
                Cf[kk] = f; }
            dsk4 = *(const f32x4*)(PIN(17) + l * SW + g * NC + 4 * jq);
        }
#define SSM_RBASE(blk_) ((blk_) == 0 ? TREAL : b * SEQ + ((blk_) - 1) * 16)
#define SSM_LOADU(dst, dstu, blk_) do { const int rb_ = SSM_RBASE(blk_); dst = *(const u32x2*)(U + (size_t)(rb_ + tq) * SW + g * NC + 4 * jq); (void)dstu; } while (0)
        u32x2 uq[4], un[4]; bf16_t uvq[4][4], uvn[4][4];
#pragma unroll
        for (int k = 0; k < 4; ++k) { un[k] = (u32x2){0u, 0u};
#pragma unroll
            for (int r = 0; r < 4; ++r) uvn[k][r] = 0; }
#define SSM_BLOCK(UQ, UVQ, blk_) do { const int blkx = (blk_); const int rbase = SSM_RBASE(blkx); \
            const s16x4 ub = __builtin_bit_cast(s16x4, UQ); \
            _Pragma("unroll") for (int f = 0; f < 8; ++f) { f32x4 d = {0.f, 0.f, 0.f, 0.f}; d = __builtin_amdgcn_mfma_f32_16x16x16bf16_1k(Af[f], ub, d, 0, 0, 0); \
                _Pragma("unroll") for (int r = 0; r < 4; ++r) bub[(16 * (f >> 1) + 4 * jq + r) * 36 + (f & 1) * 16 + tq] = d[r]; } \
            __builtin_amdgcn_fence(__ATOMIC_RELEASE, "wavefront"); asm volatile("s_waitcnt lgkmcnt(0)" ::: "memory"); \
            f32x4 bre[4], bim[4]; \
            _Pragma("unroll") for (int q = 0; q < 4; ++q) { bre[q] = *(const LAS f32x4*)(bub + p * 36 + q * 4); bim[q] = *(const LAS f32x4*)(bub + p * 36 + 16 + q * 4); } \
            _Pragma("unroll") for (int t = 0; t < 16; ++t) { \
                const float r2 = abr * hr - abi * hi + bre[t >> 2][t & 3], i2 = abr * hi + abi * hr + bim[t >> 2][t & 3]; hr = r2; hi = i2; \
                if (PASS == 1) hbuf[t * 68 + p] = pg8::cvt_pk_bf16(hr, hi); } \
            if (PASS == 1) { \
                __builtin_amdgcn_fence(__ATOMIC_RELEASE, "wavefront"); asm volatile("s_waitcnt lgkmcnt(0)" ::: "memory"); \
                f32x4 acc = {0.f, 0.f, 0.f, 0.f}; \
                _Pragma("unroll") for (int kk = 0; kk < 4; ++kk) { const bf16x8 a = *(const LAS bf16x8*)((LAS bf16_t*)hbuf + tq * 136 + kk * 32 + jq * 8); acc = __builtin_amdgcn_mfma_f32_16x16x32_bf16(Cf[kk], a, acc, 0, 0, 0); } \
                  \
                { const float uv[4] = {bf_lo(UQ.x), bf_hi(UQ.x), bf_lo(UQ.y), bf_hi(UQ.y)}; float o_[4]; \
                  _Pragma("unroll") for (int r = 0; r < 4; ++r) { const float y = acc[r] + dsk4[r] * uv[r]; const float z = 1.5957691216f * (y + 0.044715f * y * y * y); o_[r] = y * sigmoidf_(z); } \
                  u32x2 w_; w_.x = pg8::cvt_pk_bf16(o_[0], o_[1]); w_.y = pg8::cvt_pk_bf16(o_[2], o_[3]); \
                  if (blkx > 0 || b == 0) *(u32x2*)(Y + (size_t)(rbase + tq) * SW + g * NC + 4 * jq) = w_; } } \
            asm volatile("s_waitcnt lgkmcnt(0)" ::: "memory"); __builtin_amdgcn_fence(__ATOMIC_RELEASE, "wavefront"); } while (0)
        int gb0 = blk0;
        if (seg == 0) { SSM_LOADU(uq[0], uvq[0], 0); SSM_BLOCK(uq[0], uvq[0], 0); gb0 = 1; }
#pragma unroll
        for (int k = 0; k < 4; ++k) SSM_LOADU(uq[k], uvq[k], gb0 + k);
        for (int gb = gb0; gb < blk1; gb += 4) {
#pragma unroll
            for (int k = 0; k < 4; ++k) { const int nb_ = gb + 4 + k < 129 ? gb + 4 + k : 128; SSM_LOADU(un[k], uvn[k], nb_); }
            SSM_BLOCK(uq[0], uvq[0], gb); SSM_BLOCK(uq[1], uvq[1], gb + 1); SSM_BLOCK(uq[2], uvq[2], gb + 2); SSM_BLOCK(uq[3], uvq[3], gb + 3);
#pragma unroll
            for (int k = 0; k < 4; ++k) { uq[k] = un[k];
#pragma unroll
                for (int r = 0; r < 4; ++r) uvq[k][r] = uvn[k][r]; }
        }
#undef SSM_BLOCK
        if (PASS == 0) { SS[((size_t)unit * NSEG + seg) * 128 + p] = hr; SS[((size_t)unit * NSEG + seg) * 128 + 64 + p] = hi; }
    }
}
__device__ __forceinline__ float row_norm2_64(const bf16_t* p) {
    float s = 0.f;
#pragma unroll
    for (int i = 0; i < 8; ++i) { const u32x4 w = *(const u32x4*)(p + 8 * i);
        s += bf_lo(w.x) * bf_lo(w.x) + bf_hi(w.x) * bf_hi(w.x) + bf_lo(w.y) * bf_lo(w.y) + bf_hi(w.y) * bf_hi(w.y) + bf_lo(w.z) * bf_lo(w.z) + bf_hi(w.z) * bf_hi(w.z) + bf_lo(w.w) * bf_lo(w.w) + bf_hi(w.w) * bf_hi(w.w); }
    return s;
}
__device__ __forceinline__ float wave_max(float v) {
#pragma unroll
    for (int o = 1; o < 64; o <<= 1) v = fmaxf(v, __shfl_xor(v, o));
    return v;
}
__device__ __forceinline__ float sumsq8(u32x4 w) {
    return bf_lo(w.x) * bf_lo(w.x) + bf_hi(w.x) * bf_hi(w.x) + bf_lo(w.y) * bf_lo(w.y) + bf_hi(w.y) * bf_hi(w.y) + bf_lo(w.z) * bf_lo(w.z) + bf_hi(w.z) * bf_hi(w.z) + bf_lo(w.w) * bf_lo(w.w) + bf_hi(w.w) * bf_hi(w.w);
}
__device__ __forceinline__ void attn_norms(KP Pk, int gw, int ngw, int lane) {
    const bf16_t* Q = (const bf16_t*)(PWS + WS_Q); const bf16_t* Kg = (const bf16_t*)(PWS + WS_K); float* KMAX = (float*)(PWS + WS_KMAX); float* QMAX = (float*)(PWS + WS_QMAX);
    const int rsub = lane >> 3, piece = lane & 7;
    for (int task = gw; task < 128 * 32; task += ngw) {
        const int bh = task >> 5, t5 = task & 31, tile = t5 + 1, b = bh >> 3, h = bh & 7;
        const size_t base = (size_t)(b * SEQ + 64 * t5 + rsub) * AW + h * HD + piece * 8;
        u32x4 wk[8], wq[8];
#pragma unroll
        for (int i = 0; i < 8; ++i) { wk[i] = *(const u32x4*)(Kg + base + (size_t)(8 * i) * AW); wq[i] = *(const u32x4*)(Q + base + (size_t)(8 * i) * AW); }
        u32x4 wm = {0u, 0u, 0u, 0u}; u32x4 wm2 = {0u, 0u, 0u, 0u};
        if (t5 == 0) { wm = *(const u32x4*)(Kg + (size_t)(TREAL + rsub) * AW + h * HD + piece * 8); wm2 = *(const u32x4*)(Kg + (size_t)(TREAL + 8 + rsub) * AW + h * HD + piece * 8); }
        float mk = 0.f, mq = 0.f;
#pragma unroll
        for (int i = 0; i < 8; ++i) { float sk = sumsq8(wk[i]), sq = sumsq8(wq[i]);
            sk += __shfl_xor(sk, 1); sq += __shfl_xor(sq, 1); sk += __shfl_xor(sk, 2); sq += __shfl_xor(sq, 2); sk += __shfl_xor(sk, 4); sq += __shfl_xor(sq, 4);
            mk = fmaxf(mk, sk); mq = fmaxf(mq, sq); }
        float mm = 0.f;
        if (t5 == 0) { float s0 = sumsq8(wm), s1 = sumsq8(wm2); s0 += __shfl_xor(s0, 1); s1 += __shfl_xor(s1, 1); s0 += __shfl_xor(s0, 2); s1 += __shfl_xor(s1, 2); s0 += __shfl_xor(s0, 4); s1 += __shfl_xor(s1, 4); mm = fmaxf(s0, s1); }
#pragma unroll
        for (int o = 8; o < 64; o <<= 1) { mk = fmaxf(mk, __shfl_xor(mk, o)); mq = fmaxf(mq, __shfl_xor(mq, o)); mm = fmaxf(mm, __shfl_xor(mm, o)); }
        if (lane == 0) { KMAX[bh * 64 + tile] = sqrtf(mk) * 1.001f; QMAX[bh * 64 + tile] = sqrtf(mq) * 1.001f; if (t5 == 0) { KMAX[bh * 64] = sqrtf(mm) * 1.001f; QMAX[bh * 64] = 0.f; } }
    }
}
__device__ __forceinline__ void attn_phase(KP Pk, LAS unsigned char* lds, int G, int c, int tid, int wid, int lane) {
    const bf16_t* Q = (const bf16_t*)(PWS + WS_Q); const bf16_t* Kg = (const bf16_t*)(PWS + WS_K); const bf16_t* VT = (const bf16_t*)(PWS + WS_VT);
    bf16_t* YB = (bf16_t*)(PWS + WS_YB); const float* CUM = (const float*)(PWS + WS_CUM);
    LAS unsigned char* Kl = lds; LAS unsigned char* Vl = lds + 9216;
    const int ql = lane & 15, j = lane >> 4;
    for (int u = c; u < 1024 + NH; u += G) {
        const bool tb = u >= 1024;
        int bh, qt = 0, ntile;
        if (!tb) { const int i_ = u >> 8, cc = u & 255, hh = (i_ << 1) | (cc & 1), bb = cc >> 4, qq = (cc >> 1) & 7; bh = bb * 8 + hh; qt = (i_ & 1) ? 7 - qq : qq; ntile = 4 * qt + 5; } else { bh = u - 1024; ntile = 1; }
        const int b = bh >> 3, h = bh & 7;
        const bool active = tb ? (wid == 0) : true;
        int qpos[2], qrow[2]; float cumq[2]; bf16x8 qf[2][2];
#pragma unroll
        for (int gq = 0; gq < 2; ++gq) { qpos[gq] = tb ? ql : 16 + 256 * qt + 32 * wid + 16 * gq + ql; qrow[gq] = tb ? TREAL + ql : b * SEQ + qpos[gq] - 16;
            qf[gq][0] = *(const bf16x8*)(Q + (size_t)qrow[gq] * AW + h * HD + j * 8); qf[gq][1] = *(const bf16x8*)(Q + (size_t)qrow[gq] * AW + h * HD + 32 + j * 8);
            cumq[gq] = CUM[(size_t)bh * LPOS + qpos[gq]]; }
        const int wmax = tb ? 15 : 16 + 256 * qt + 32 * wid + 31, wmin = tb ? 0 : 16 + 256 * qt + 32 * wid;
        float m_run[2] = {-1e30f, -1e30f}, l_run[2] = {0.f, 0.f}; f32x4 O[2][4];
#pragma unroll
        for (int gq = 0; gq < 2; ++gq)
#pragma unroll
            for (int i = 0; i < 4; ++i) O[gq][i] = (f32x4){0.f, 0.f, 0.f, 0.f};
        const int skey = tid >> 3, spiece = tid & 7;
        u32x4 kreg, vreg; f32x4 ckn[2][2], ckc[2][2];
#define ATT_LOAD(kt_) do { const int kt__ = (kt_); \
            const bool valid = kt__ > 0 || skey < 16; const int grow = kt__ == 0 ? TREAL + (skey & 15) : b * SEQ + 64 * (kt__ - 1) + skey; \
            kreg = (u32x4){0u, 0u, 0u, 0u}; if (valid) kreg = *(const u32x4*)(Kg + (size_t)grow * AW + h * HD + spiece * 8); \
            const bool validp = kt__ > 0 || spiece < 2; const int gcol = kt__ == 0 ? TREAL + (spiece & 1) * 8 : b * SEQ + 64 * (kt__ - 1) + spiece * 8; \
            vreg = (u32x4){0u, 0u, 0u, 0u}; if (validp) vreg = *(const u32x4*)(VT + (size_t)(h * HD + skey) * T + gcol); \
            const int kp0__ = kt__ == 0 ? 0 : 16 + 64 * (kt__ - 1); \
            _Pragma("unroll") for (int g32 = 0; g32 < 2; ++g32) { const int kb = 32 * g32 + 8 * j; ckn[g32][0] = (f32x4){0.f, 0.f, 0.f, 0.f}; ckn[g32][1] = (f32x4){0.f, 0.f, 0.f, 0.f}; \
                if (kt__ > 0 || kb < 16) { const f32x4* cp = (const f32x4*)(CUM + (size_t)bh * LPOS + kp0__ + kb); ckn[g32][0] = cp[0]; ckn[g32][1] = cp[1]; } } } while (0)
        int jstart = 0;
        if (!tb) { const float* KMAX = (const float*)(PWS + WS_KMAX) + bh * 64; const float* QMAX = (const float*)(PWS + WS_QMAX) + bh * 64;
            const float qmax = fmaxf(fmaxf(QMAX[4 * qt + 1], QMAX[4 * qt + 2]), fmaxf(QMAX[4 * qt + 3], QMAX[4 * qt + 4]));
            const float kself = fmaxf(fmaxf(KMAX[4 * qt + 1], KMAX[4 * qt + 2]), fmaxf(KMAX[4 * qt + 3], KMAX[4 * qt + 4])); const float cum0 = CUM[(size_t)bh * LPOS + 16 + 256 * qt];
            const bool cand = lane <= 4 * qt; float kp = cand ? KMAX[lane] : 0.f;
#pragma unroll
            for (int o = 1; o < 64; o <<= 1) { const float t_ = __shfl_up(kp, o); if (lane >= o) kp = fmaxf(kp, t_); }
            const float kend = cand ? CUM[(size_t)bh * LPOS + 64 * lane + 15] : 0.f;
            const bool skip = cand && (qmax * (kp + kself) + cum0 - kend <= -36.0f);
            jstart = __popcll(__ballot(skip)); }
        ATT_LOAD(jstart);
        for (int kt = jstart; kt < ntile; ++kt) {
            __syncthreads();
            *(LAS u32x4*)(Kl + skey * 144 + spiece * 16) = kreg;
            *(LAS u32x4*)(Vl + skey * 144 + spiece * 16) = vreg;
#pragma unroll
            for (int g32 = 0; g32 < 2; ++g32) { ckc[g32][0] = ckn[g32][0]; ckc[g32][1] = ckn[g32][1]; }
            __syncthreads();
            if (kt + 1 < ntile) ATT_LOAD(kt + 1);
            const int kpos0 = kt == 0 ? 0 : 16 + 64 * (kt - 1);
            if (active && kpos0 <= wmax) {
                f32x4 s[2][2][2];
#pragma unroll
                for (int g32 = 0; g32 < 2; ++g32)
#pragma unroll
                    for (int blk = 0; blk < 2; ++blk) { const int key = 32 * g32 + 8 * (ql >> 2) + 4 * blk + (ql & 3);
                        const bf16x8 kf0 = *(const LAS bf16x8*)(Kl + key * 144 + j * 16), kf1 = *(const LAS bf16x8*)(Kl + key * 144 + 64 + j * 16);
#pragma unroll
                        for (int gq = 0; gq < 2; ++gq) { f32x4 a = {0.f, 0.f, 0.f, 0.f};
                            a = __builtin_amdgcn_mfma_f32_16x16x32_bf16(kf0, qf[gq][0], a, 0, 0, 0); a = __builtin_amdgcn_mfma_f32_16x16x32_bf16(kf1, qf[gq][1], a, 0, 0, 0); s[gq][g32][blk] = a; } }
                const bool need_mask = kt == 0 || kpos0 + 63 > wmin;
                bf16x8 pf[2][2]; float alpha[2];
#pragma unroll
                for (int gq = 0; gq < 2; ++gq) {
                    float tmax = -1e30f;
                    if (need_mask) {
#pragma unroll
                        for (int g32 = 0; g32 < 2; ++g32) { const int kb = 32 * g32 + 8 * j;
#pragma unroll
                            for (int blk = 0; blk < 2; ++blk)
#pragma unroll
                                for (int r = 0; r < 4; ++r) { const int key = kb + 4 * blk + r, kpos = kpos0 + key; const bool valid = kpos <= qpos[gq] && (kt > 0 || key < 16);
                                    const float v = s[gq][g32][blk][r] + (cumq[gq] - ckc[g32][blk][r]); const float sv = valid ? v : -1e30f; s[gq][g32][blk][r] = sv; tmax = fmaxf(tmax, sv); } }
                    } else {
#pragma unroll
                        for (int g32 = 0; g32 < 2; ++g32)
#pragma unroll
                            for (int blk = 0; blk < 2; ++blk)
#pragma unroll
                                for (int r = 0; r < 4; ++r) { const float v = s[gq][g32][blk][r] + (cumq[gq] - ckc[g32][blk][r]); s[gq][g32][blk][r] = v; tmax = fmaxf(tmax, v); }
                    }
                    tmax = fmaxf(tmax, __shfl_xor(tmax, 16)); tmax = fmaxf(tmax, __shfl_xor(tmax, 32));
                    const float m_new = fmaxf(m_run[gq], tmax); alpha[gq] = fast_exp2(m_run[gq] - m_new); m_run[gq] = m_new;
                    float ps = 0.f;
#pragma unroll
                    for (int g32 = 0; g32 < 2; ++g32) { float pv[8];
#pragma unroll
                        for (int blk = 0; blk < 2; ++blk)
#pragma unroll
                            for (int r = 0; r < 4; ++r) { const float e = fast_exp2(s[gq][g32][blk][r] - m_new); pv[blk * 4 + r] = e; ps += e; }
                        u32x4 w; w.x = pg8::cvt_pk_bf16(pv[0], pv[1]); w.y = pg8::cvt_pk_bf16(pv[2], pv[3]); w.z = pg8::cvt_pk_bf16(pv[4], pv[5]); w.w = pg8::cvt_pk_bf16(pv[6], pv[7]);
                        pf[gq][g32] = __builtin_bit_cast(bf16x8, w); }
                    l_run[gq] = l_run[gq] * alpha[gq] + ps;
                }
#pragma unroll
                for (int db = 0; db < 4; ++db) {
#pragma unroll
                    for (int gq = 0; gq < 2; ++gq) O[gq][db] = O[gq][db] * alpha[gq];
#pragma unroll
                    for (int g32 = 0; g32 < 2; ++g32) { const bf16x8 vf = *(const LAS bf16x8*)(Vl + (16 * db + ql) * 144 + (32 * g32 + 8 * j) * 2);
#pragma unroll
                        for (int gq = 0; gq < 2; ++gq) O[gq][db] = __builtin_amdgcn_mfma_f32_16x16x32_bf16(vf, pf[gq][g32], O[gq][db], 0, 0, 0); } }
            }
        }
        if (active) {
#pragma unroll
            for (int gq = 0; gq < 2; ++gq) { if (tb && gq == 1) break;
                float lt = l_run[gq]; lt += __shfl_xor(lt, 16); lt += __shfl_xor(lt, 32);
                const float inv = 1.0f / lt;
#pragma unroll
                for (int db = 0; db < 4; ++db) { u32x2 w; w.x = pg8::cvt_pk_bf16(O[gq][db][0] * inv, O[gq][db][1] * inv); w.y = pg8::cvt_pk_bf16(O[gq][db][2] * inv, O[gq][db][3] * inv);
                    *(u32x2*)(YB + (size_t)qrow[gq] * AW + h * HD + 16 * db + 4 * j) = w; } }
        }
    }
    __syncthreads();
}


__device__ __forceinline__ f32x4 skinny_dot(const bf16_t* A, const bf16_t* W, int K, int len, int lane) {
    const bf16_t* ap = A + (size_t)(lane & 15) * K + 8 * (lane >> 4); const bf16_t* wp = W + (size_t)(lane & 15) * K + 8 * (lane >> 4);
    f32x4 acc = {0.f, 0.f, 0.f, 0.f};
#pragma unroll 4
    for (int k0 = 0; k0 < len; k0 += 32) { const bf16x8 wf = *(const bf16x8*)(wp + k0), af = *(const bf16x8*)(ap + k0); acc = __builtin_amdgcn_mfma_f32_16x16x32_bf16(wf, af, acc, 0, 0, 0); }
    return acc;
}
__device__ __forceinline__ f32x4 skinny_dot_wg(const bf16_t* A, const bf16_t* W, int K, LAS f32x4* red, int wid, int lane) {
    const int ks = K >> 3;
    red[wid * 64 + lane] = skinny_dot(A + wid * ks, W + wid * ks, K, ks, lane);
    __syncthreads();
    f32x4 t = {0.f, 0.f, 0.f, 0.f};
    if (wid == 0) {
#pragma unroll
        for (int w = 0; w < 8; ++w) t = t + red[w * 64 + lane]; }
    __syncthreads();
    return t;
}
__device__ __forceinline__ float meta_rs(const float* SSQM, int m) {
    const f32x4* p = (const f32x4*)(SSQM + m * 64); float s = 0.f;
#pragma unroll
    for (int i = 0; i < 16; ++i) { const f32x4 a = p[i]; s += (a.x + a.y) + (a.z + a.w); }
    return __builtin_amdgcn_rsqf(s * (1.0f / D) + RMS_EPS);
}
#define SKINNY_ARGS LAS f32x4* red, int c, int G, int wid, int lane
template <int MODE>
__device__ __forceinline__ void skinny_pair(const bf16_t* A, const bf16_t* W, int N, int K, bf16_t* O, int ldo, const float* SSQM, SKINNY_ARGS) {
    const int m = lane & 15, j = lane >> 4;
    for (int tg = c; tg < N / 16; tg += G) {
        f32x4 a = skinny_dot_wg(A + (size_t)TREAL * K, W + (size_t)tg * 16 * K, K, red, wid, lane);
        if (wid == 0) {
            if (MODE == 0) a = a * meta_rs(SSQM, m);
            f32x4 b;
#pragma unroll
            for (int i = 0; i < 4; ++i) b[i] = __shfl_xor(a[i], 16);
            if ((j & 1) == 0) { float v[4];
#pragma unroll
                for (int i = 0; i < 4; ++i) v[i] = MODE == 0 ? a[i] * sigmoidf_(a[i]) * b[i] : a[i] * sigmoidf_(b[i]);
                u32x2 w; w.x = pg8::cvt_pk_bf16(v[0], v[1]); w.y = pg8::cvt_pk_bf16(v[2], v[3]);
                *(u32x2*)(O + (size_t)(TREAL + m) * ldo + tg * 8 + 2 * j) = w; }
        }
    }
}
__device__ __forceinline__ void skinny_resid(const bf16_t* A, const bf16_t* W, int K, float scale, float* hmeta, bf16_t* HB, float* SSQM, SKINNY_ARGS) {
    const int m = lane & 15, j = lane >> 4;
    for (int tg = c; tg < D / 16; tg += G) { const int n0 = tg * 16;
        const f32x4 acc = skinny_dot_wg(A + (size_t)TREAL * K, W + (size_t)n0 * K, K, red, wid, lane);
        if (wid == 0) {
            f32x4* hp = (f32x4*)(hmeta + (size_t)m * D + n0 + 4 * j); f32x4 v = *hp; v = v + acc * scale; *hp = v;
            float ss = (v.x * v.x + v.y * v.y) + (v.z * v.z + v.w * v.w);
            u32x2 w; w.x = pg8::cvt_pk_bf16(v.x, v.y); w.y = pg8::cvt_pk_bf16(v.z, v.w); *(u32x2*)(HB + (size_t)(TREAL + m) * D + n0 + 4 * j) = w;
            ss += __shfl_xor(ss, 16); ss += __shfl_xor(ss, 32);
            if (j == 0) SSQM[m * 64 + tg] = ss;
        }
    }
}
__device__ __forceinline__ void skinny_in(const bf16_t* A, const bf16_t* WIN, const bf16_t* WV, bf16_t* U, bf16_t* Q, bf16_t* Kb, bf16_t* VT, bf16_t* GATES, float* FLOG,
                                          const float* b_gate, const float* b_f, const float* SSQM, SKINNY_ARGS) {
    const int m = lane & 15, j = lane >> 4;
    for (int tg = c; tg < 225 + 32; tg += G) {
        const bool isv = tg >= 225; const int n0 = isv ? (tg - 225) * 16 : tg * 16;
        f32x4 a = skinny_dot_wg(A + (size_t)TREAL * D, (isv ? WV : WIN) + (size_t)n0 * D, D, red, wid, lane);
        if (wid == 0) {
            a = a * meta_rs(SSQM, m);
            const int c0 = n0 + 4 * j;
            if (isv) {
#pragma unroll
                for (int r = 0; r < 4; ++r) VT[(size_t)(c0 + r) * T + TREAL + m] = (bf16_t)f2bf(a[r]);
            } else if (n0 < 1536) {
                bf16_t* base = n0 < 512 ? U + c0 : (n0 < 1024 ? Q + (c0 - 512) : Kb + (c0 - 1024));
                if (n0 >= 512 && n0 < 1024) a = a * (0.125f * LOG2E);
                u32x2 w; w.x = pg8::cvt_pk_bf16(a[0], a[1]); w.y = pg8::cvt_pk_bf16(a[2], a[3]); *(u32x2*)(base + (size_t)(TREAL + m) * 512) = w;
            } else if (n0 < 3584) {
                const int gc = c0 - 1536; const f32x4 bv = *(const f32x4*)(b_gate + gc); float v[4];
#pragma unroll
                for (int i = 0; i < 4; ++i) v[i] = sigmoidf_(a[i] + bv[i]);
                u32x2 w; w.x = pg8::cvt_pk_bf16(v[0], v[1]); w.y = pg8::cvt_pk_bf16(v[2], v[3]); *(u32x2*)(GATES + (size_t)(TREAL + m) * 2048 + gc) = w;
            } else if (j < 2) {
                const f32x4 bv = *(const f32x4*)(b_f + 4 * j); f32x4 z = a + bv;
#pragma unroll
                for (int i = 0; i < 4; ++i) z[i] = (fminf(z[i], 0.f) - __logf(1.0f + __expf(-fabsf(z[i])))) * LOG2E;
                *(f32x4*)(FLOG + (size_t)(TREAL + m) * 8 + 4 * j) = z;
            }
        }
    }
}
__device__ __forceinline__ void f_rows(const bf16_t* A, const bf16_t* WF, float* FLOG, const float* b_f, const float* SSQ, int gw, int ngw, int lane) {
    const int m = lane & 15, j = lane >> 4;
    for (int grp = gw; grp < TREAL / 16; grp += ngw) { const int r0 = grp * 16;
        const bf16_t* ap = A + (size_t)(r0 + m) * D + 8 * j; const bf16_t* wp = WF + (size_t)m * D + 8 * j;
        f32x4 acc = {0.f, 0.f, 0.f, 0.f};
#pragma unroll 8
        for (int k0 = 0; k0 < D; k0 += 32) { const bf16x8 wf = *(const bf16x8*)(wp + k0), af = *(const bf16x8*)(ap + k0); acc = __builtin_amdgcn_mfma_f32_16x16x32_bf16(wf, af, acc, 0, 0, 0); }
        if (j < 2) { const f32x4 bv = *(const f32x4*)(b_f + 4 * j); f32x4 z = acc * row_rs(SSQ, (size_t)(r0 + m)) + bv;
#pragma unroll
            for (int i = 0; i < 4; ++i) z[i] = (fminf(z[i], 0.f) - __logf(1.0f + __expf(-fabsf(z[i])))) * LOG2E;
            *(f32x4*)(FLOG + (size_t)(r0 + m) * 8 + 4 * j) = z; }
    }
}
__device__ __forceinline__ void skinny_branch(const bf16_t* YA, const bf16_t* YB, const bf16_t* WA, const bf16_t* WB, const bf16_t* GATES, bf16_t* MERGED, SKINNY_ARGS) {
    const int m = lane & 15, j = lane >> 4;
    for (int tg = c; tg < D / 16; tg += G) { const int c0 = tg * 16 + 4 * j;
        const f32x4 a = skinny_dot_wg(YA + (size_t)TREAL * SW, WA + (size_t)tg * 16 * SW, SW, red, wid, lane), b = skinny_dot_wg(YB + (size_t)TREAL * AW, WB + (size_t)tg * 16 * AW, AW, red, wid, lane);
        if (wid == 0) {
            const u32x2 ga = *(const u32x2*)(GATES + (size_t)(TREAL + m) * 2048 + c0), gb = *(const u32x2*)(GATES + (size_t)(TREAL + m) * 2048 + 1024 + c0);
            const float v0 = bf_lo(ga.x) * a[0] + bf_lo(gb.x) * b[0], v1 = bf_hi(ga.x) * a[1] + bf_hi(gb.x) * b[1], v2 = bf_lo(ga.y) * a[2] + bf_lo(gb.y) * b[2], v3 = bf_hi(ga.y) * a[3] + bf_hi(gb.y) * b[3];
            u32x2 w; w.x = pg8::cvt_pk_bf16(v0, v1); w.y = pg8::cvt_pk_bf16(v2, v3); *(u32x2*)(MERGED + (size_t)(TREAL + m) * D + c0) = w; }
    }
}

#define XB_TMO      128
#define XB_XCNT(j)  (256  + 64 * (j))
#define XB_XSUB(j)  (1280 + 64 * (j))
#define XB_XGEN(j)  (2304 + 64 * (j))
#define XB_TOP      3328
#define XB_TOPGEN   3392
#define XCD_BAR_WORDS 3456
#define XB_SPIN_CAP (1u << 20)
__device__ __forceinline__ unsigned xb_ld(unsigned* p)              { return __hip_atomic_load(p, __ATOMIC_RELAXED, __HIP_MEMORY_SCOPE_AGENT); }
__device__ __forceinline__ unsigned xb_add(unsigned* p, unsigned v) { return __hip_atomic_fetch_add(p, v, __ATOMIC_RELAXED, __HIP_MEMORY_SCOPE_AGENT); }
__device__ __forceinline__ unsigned xb_xcc_id() { return (unsigned)__builtin_amdgcn_s_getreg((3 << 11) | 20) & 0xFu; }
#define XB_SPIN(cond, bar) do { unsigned _sp = 0; while (cond) { __builtin_amdgcn_s_sleep(1); \
    if ((++_sp & 255u) == 0u) { if (xb_ld(&(bar)[XB_TMO])) break; if (_sp > XB_SPIN_CAP) { atomicAdd(&(bar)[XB_TMO], 1u); break; } } } } while (0)
struct XcdBarrier { unsigned* bar; unsigned x; volatile LAS unsigned* st; };
__device__ __forceinline__ XcdBarrier xcd_barrier_post(unsigned* bar, volatile LAS unsigned* st) {
    XcdBarrier b; b.bar = bar; b.x = xb_xcc_id(); b.st = st;
    if (threadIdx.x == 0) (void)xb_add(&bar[XB_XCNT(b.x)], 1u);
    return b;
}
__device__ __forceinline__ void xcd_barrier_complete(unsigned* bar, unsigned x, unsigned& nloc, unsigned& nx) {
    const unsigned G = gridDim.x * gridDim.y * gridDim.z;
    unsigned sum, cnt, mine, sp = 0u;
    for (;;) {
        sum = 0u; cnt = 0u; mine = 0u;
#pragma unroll
        for (unsigned j = 0; j < 16; ++j) { const unsigned c = xb_ld(&bar[XB_XCNT(j)]); sum += c; cnt += (c > 0u) ? 1u : 0u; mine = (j == x) ? c : mine; }
        if (sum == G) break;
        __builtin_amdgcn_s_sleep(1);
        if ((++sp & 255u) == 0u) { if (xb_ld(&bar[XB_TMO])) break; if (sp > XB_SPIN_CAP) { atomicAdd(&bar[XB_TMO], 1u); break; } }
    }
    nloc = mine > 0u ? mine : 1u; nx = cnt > 0u ? cnt : 1u;
}
__device__ __forceinline__ void xcd_barrier(const XcdBarrier& b) {
    asm volatile("s_waitcnt vmcnt(0)" ::: "memory");
    __syncthreads();
    if (threadIdx.x == 0) {
        unsigned* bar = b.bar;
        __builtin_amdgcn_s_waitcnt(0);
        unsigned nloc = b.st[0], nx = b.st[1];
        if (nloc == 0u) { xcd_barrier_complete(bar, b.x, nloc, nx); b.st[0] = nloc; b.st[1] = nx; }
        const unsigned old = xb_add(&bar[XB_XSUB(b.x)], 1u);
        const unsigned gen = old / nloc;
        if (old + 1u == (gen + 1u) * nloc) {
            __builtin_amdgcn_fence(__ATOMIC_RELEASE, "agent");
            asm volatile("s_waitcnt vmcnt(0)" ::: "memory");
            const unsigned og = xb_add(&bar[XB_TOP], 1u);
            const unsigned tg = og / nx;
            if (og + 1u == (tg + 1u) * nx) xb_add(&bar[XB_TOPGEN], 1u);
            else XB_SPIN(xb_ld(&bar[XB_TOPGEN]) == tg, bar);
            __builtin_amdgcn_fence(__ATOMIC_ACQUIRE, "agent");
            xb_add(&bar[XB_XGEN(b.x)], 1u);
            asm volatile("s_waitcnt vmcnt(0)" ::: "memory");
        } else {
            XB_SPIN(xb_ld(&bar[XB_XGEN(b.x)]) == gen, bar);
            __builtin_amdgcn_fence(__ATOMIC_ACQUIRE, "agent");
            asm volatile("s_waitcnt vmcnt(0)" ::: "memory");
        }
    }
    __syncthreads();
}

constexpr int NPH = 22;
constexpr int LDS_BYTES = 147456;
__global__ void __launch_bounds__(512, 2) mk_fwd(Params P) {
    extern __shared__ __attribute__((aligned(16))) unsigned char lds[];
    const int G = gridDim.x, ngw = G * 8;
    LAS unsigned char* lds3 = (LAS unsigned char*)lds;
    volatile LAS unsigned* bst = (volatile LAS unsigned*)(lds3 + 131072 + 64);
    if (threadIdx.x < 4) bst[threadIdx.x] = 0u;
    __syncthreads();
    XcdBarrier xbar; xbar.bar = (unsigned*)(GAS unsigned*)(P.ws + WS_BAR); xbar.x = 0; xbar.st = bst;
    if (!MK_MULTI) xbar = xcd_barrier_post((unsigned*)(GAS unsigned*)(P.ws + WS_BAR), bst);
    int ph = 0;
#define RUN() (ph >= P.ph_lo && ph < P.ph_hi)
#define SEAM() do { ++ph; if (!MK_MULTI && ph > P.ph_lo && ph < P.ph_hi) { if (ph == 1) cg::this_grid().sync(); else xcd_barrier(xbar); } } while (0)
#define SKRED ((LAS f32x4*)(lds3 + 131072 + 8192))
#define PH_BEGIN int c = blockIdx.x; KP Pk = (KP)__builtin_amdgcn_kernarg_segment_ptr(); int tid = threadIdx.x; asm volatile("" : "+s"(c), "+s"(Pk), "+v"(tid)); unsigned char* ws = PWS; \
    const int lane = tid & 63, wid = __builtin_amdgcn_readfirstlane(tid >> 6); const int gw = c * 8 + wid; (void)lane; \
    float* hmain = POUT; float* hmeta = (float*)(ws + WS_HMETA); bf16_t* XN = (bf16_t*)(ws + WS_XN); bf16_t* HID = (bf16_t*)(ws + WS_R); \
    bf16_t *Ub = (bf16_t*)(ws + WS_U), *Qb = (bf16_t*)(ws + WS_Q), *Kb = (bf16_t*)(ws + WS_K), *VTb = (bf16_t*)(ws + WS_VT), *GATES = (bf16_t*)(ws + WS_GATES); \
    bf16_t* YSSM = (bf16_t*)(ws + WS_YSSM); bf16_t* YA = Ub; bf16_t* YB = (bf16_t*)(ws + WS_YB); bf16_t* MERGED = Kb; bf16_t* wb = (bf16_t*)(ws + WS_W) + (size_t)l * W_LAYER; \
    (void)hmain; (void)hmeta; (void)HID; (void)GATES; (void)YSSM; (void)YA; (void)YB; (void)MERGED; (void)wb; (void)VTb; (void)gw; (void)XN; (void)Ub; (void)Qb; (void)Kb;
    { const int l = 0; if (RUN()) { PH_BEGIN convert_weights(Pk, lds3, gw, ngw, wid, lane); norm_rows<1>(Pk, nullptr, gw, ngw, lane); } }
    SEAM();
    for (int l = 0; l < 2; ++l) {
        if (RUN()) { PH_BEGIN skinny_pair<0>(XN, wb + WO_W1, 2 * DFF, D, HID, DFF, (const float*)(ws + WS_SSQM), SKRED, c, G, wid, lane); pg8::Gemm g{XN, wb + WO_W1, nullptr, nullptr, D}; pg8::Sched2 S; S.init(TREAL, 2 * DFF, 0, 0, G, c); EpiPair<0> E{HID, DFF, (const float*)(ws + WS_SSQ)}; pg8::gemm_phase(lds3, g, S, E); }
        SEAM();
        if (RUN()) { PH_BEGIN skinny_resid(HID, wb + WO_W2, DFF, 0.5f, hmeta, XN, (float*)(ws + WS_SSQM), SKRED, c, G, wid, lane); pg8::Gemm g{HID, wb + WO_W2, nullptr, nullptr, DFF}; pg8::Sched2 S; S.init(TREAL, D, 0, 0, G, c); if (l == 0) { EpiResid<true> E{PIN(0), 0.5f, XN, (float*)(ws + WS_SSQ), (LAS float*)(lds3 + 131072 + 2048)}; pg8::gemm_phase(lds3, g, S, E); } else { EpiResid<false> E{nullptr, 0.5f, XN, (float*)(ws + WS_SSQ), (LAS float*)(lds3 + 131072 + 2048)}; pg8::gemm_phase(lds3, g, S, E); } }
        SEAM();
        if (RUN()) { PH_BEGIN f_rows(XN, wb + WO_WIN + (size_t)3584 * D, (float*)(ws + WS_FLOG), PIN(9) + l * NH, (const float*)(ws + WS_SSQ), gw, ngw, lane); skinny_in(XN, wb + WO_WIN, wb + WO_WV, Ub, Qb, Kb, VTb, GATES, (float*)(ws + WS_FLOG), PIN(8) + l * 2 * D, PIN(9) + l * NH, (const float*)(ws + WS_SSQM), SKRED, c, G, wid, lane); pg8::Gemm g{XN, wb + WO_WIN, wb + WO_WV, XN, D}; pg8::Sched2 S; S.init(TREAL, 3584, 512, TREAL, G, c);
            EpiIn E{Ub, Qb, Kb, VTb, GATES, (float*)(ws + WS_FLOG), PIN(8) + l * 2 * D, PIN(9) + l * NH, (const float*)(ws + WS_SSQ)}; pg8::gemm_phase(lds3, g, S, E); }
        SEAM();
        if (RUN()) { PH_BEGIN for (int rep = 0; rep < REP_SSM; ++rep) { cumscan(Pk, gw, ngw, lane); attn_norms(Pk, gw, ngw, lane); ssm_pass<0>(Pk, l, lds3, gw, ngw, wid, lane); } }
        SEAM();
        if (RUN()) { PH_BEGIN attn_phase(Pk, lds3, G, c, tid, wid, lane); ssm_pass<1>(Pk, l, lds3, gw, ngw, wid, lane); }
        SEAM();
        if (RUN()) { PH_BEGIN skinny_pair<1>(YSSM, wb + WO_GLU, 2 * SW, SW, YA, SW, nullptr, SKRED, c, G, wid, lane); pg8::Gemm g{YSSM, wb + WO_GLU, nullptr, nullptr, SW}; pg8::Sched2 S; S.init(TREAL, 2 * SW, 0, 0, G, c); EpiPair<1> E{YA, SW, nullptr}; pg8::gemm_phase(lds3, g, S, E); }
        SEAM();
        if (RUN()) { { PH_BEGIN skinny_branch(YA, YB, wb + WO_BA, wb + WO_BB, GATES, MERGED, SKRED, c, G, wid, lane); pg8::Gemm g{YA, wb + WO_BA, nullptr, nullptr, SW}; pg8::Sched2 S; S.init(TREAL, D, 0, 0, G, c); EpiBranch<0> E{GATES, MERGED}; pg8::gemm_phase(lds3, g, S, E); }
                     { PH_BEGIN pg8::Gemm g{YB, wb + WO_BB, nullptr, nullptr, AW}; pg8::Sched2 S; S.init(TREAL, D, 0, 0, G, c); EpiBranch<1> E{GATES, MERGED}; pg8::gemm_phase(lds3, g, S, E); } }
        SEAM();
        if (RUN()) { PH_BEGIN skinny_resid(MERGED, wb + WO_O, D, 1.0f, hmeta, XN, (float*)(ws + WS_SSQM), SKRED, c, G, wid, lane); pg8::Gemm g{MERGED, wb + WO_O, nullptr, nullptr, D}; pg8::Sched2 S; S.init(TREAL, D, 0, 0, G, c); EpiResid<false> E{nullptr, 1.0f, XN, (float*)(ws + WS_SSQ), (LAS float*)(lds3 + 131072 + 2048)}; pg8::gemm_phase(lds3, g, S, E); }
        SEAM();
        if (RUN()) { PH_BEGIN skinny_pair<0>(XN, wb + WO_W1B, 2 * DFF, D, HID, DFF, (const float*)(ws + WS_SSQM), SKRED, c, G, wid, lane); pg8::Gemm g{XN, wb + WO_W1B, nullptr, nullptr, D}; pg8::Sched2 S; S.init(TREAL, 2 * DFF, 0, 0, G, c); EpiPair<0> E{HID, DFF, (const float*)(ws + WS_SSQ)}; pg8::gemm_phase(lds3, g, S, E); }
        SEAM();
        if (RUN()) { PH_BEGIN skinny_resid(HID, wb + WO_W2B, DFF, 0.5f, hmeta, XN, (float*)(ws + WS_SSQM), SKRED, c, G, wid, lane); pg8::Gemm g{HID, wb + WO_W2B, nullptr, nullptr, DFF}; pg8::Sched2 S; S.init(TREAL, D, 0, 0, G, c); EpiResid<false> E{nullptr, 0.5f, XN, (float*)(ws + WS_SSQ), (LAS float*)(lds3 + 131072 + 2048)}; pg8::gemm_phase(lds3, g, S, E); }
        SEAM();
    }
    { const int l = 0; if (RUN()) { PH_BEGIN norm_rows<2>(Pk, PIN(26), gw, ngw, lane); } }
}

extern "C" void kernel_launch(void* const* d_in, const int* in_sizes, int n_in, void* d_out, int out_size, void* d_ws, size_t ws_size, hipStream_t stream) {
    static int ready = 0;
    if (!ready) {
        if (n_in != 27 || ws_size < WS_END) { fprintf(stderr, "kernel_launch: unexpected inputs (n_in %d, ws %zu < %zu)\n", n_in, ws_size, (size_t)WS_END); ready = -1; return; }
        if (hipFuncSetAttribute((const void*)mk_fwd, hipFuncAttributeMaxDynamicSharedMemorySize, LDS_BYTES) != hipSuccess) { fprintf(stderr, "kernel_launch: hipFuncSetAttribute failed\n"); ready = -1; return; }
        ready = 1;
    }
    if (ready < 0) return;
    Params p{};
    for (int i = 0; i < 27; ++i) p.in[i] = (const float*)d_in[i];
    p.out = (float*)d_out; p.ws = (unsigned char*)d_ws;
#if MK_MULTI
    for (int ph = 0; ph < NPH; ++ph) { p.ph_lo = ph; p.ph_hi = ph + 1; hipLaunchKernelGGL(mk_fwd, dim3(256), dim3(512), LDS_BYTES, stream, p); }
#else
    p.ph_lo = 0; p.ph_hi = NPH;
    (void)hipMemsetAsync((unsigned char*)d_ws + WS_BAR, 0, BAR_BYTES, stream);
    void* args[] = {&p};
    hipError_t e = hipLaunchCooperativeKernel((const void*)mk_fwd, dim3(256), dim3(512), args, LDS_BYTES, stream);
    if (e != hipSuccess) fprintf(stderr, "cooperative launch failed: %s\n", hipGetErrorString(e));
#endif
}
```
